# Optimizing an MI355X kernel written in HIP

```python
import jax, jax.numpy as jnp
from jax import lax
import numpy as np

D_MODEL = 1024
BATCH = 2
SEQ = 8192
DEPTH = 4

HEAD_DIM = 64
D_MIX = D_MODEL
N_Q_HEADS = 8
N_KV_HEADS = 2
GQA_GROUP = N_Q_HEADS // N_KV_HEADS
ATTN_W = N_Q_HEADS * HEAD_DIM
KV_W = N_KV_HEADS * HEAD_DIM
N_SG_HEADS = 4
SG_W = N_SG_HEADS * HEAD_DIM
SG_CHUNK = 128
N_CONV_GROUPS = 4
CONV_W = N_CONV_GROUPS * HEAD_DIM
CONV_K = 3
D_FF = 2816
Q_BLOCK = 128
GRID_W = 64
ROPE_THETA = 10000.0
AXIS_DIM = HEAD_DIM // 2
EPS = 1e-6
PROJ_SPLITS = (ATTN_W, KV_W, KV_W, SG_W, SG_W, CONV_W, CONV_W, CONV_W)
PROJ_W = sum(PROJ_SPLITS)

kernel_name = "hybrid_parallel_heads_encoder"


def _rmsnorm(x, g):
    x32 = x.astype(jnp.float32)
    y = x32 * lax.rsqrt(jnp.mean(x32 * x32, axis=-1, keepdims=True) + EPS)
    return y.astype(x.dtype) * g


def _dwconv3(x, w):
    xp = jnp.pad(x, ((0, 0), (1, 1), (0, 0)))
    return xp[:, :-2] * w[0] + xp[:, 1:-1] * w[1] + xp[:, 2:] * w[2]


def _axial_angles(seq):
    rows = seq // GRID_W
    row = jnp.broadcast_to(jnp.arange(rows)[:, None], (rows, GRID_W)).reshape(-1)
    col = jnp.broadcast_to(jnp.arange(GRID_W)[None, :], (rows, GRID_W)).reshape(-1)
    inv = 1.0 / (ROPE_THETA ** (jnp.arange(AXIS_DIM // 2, dtype=jnp.float32) * 2.0 / AXIS_DIM))
    ang_r = row.astype(jnp.float32)[:, None] * inv[None, :]
    ang_c = col.astype(jnp.float32)[:, None] * inv[None, :]
    return ang_r, ang_c


def _rotate(x, cos, sin):
    x1, x2 = jnp.split(x, 2, axis=-1)
    return jnp.concatenate([x1 * cos - x2 * sin, x1 * sin + x2 * cos], axis=-1)


def _axial_rope(x, tabs):
    cr, sr, cc, sc = tabs
    return jnp.concatenate([_rotate(x[..., :AXIS_DIM], cr, sr),
                            _rotate(x[..., AXIS_DIM:], cc, sc)], axis=-1)


def _block_attention(q, k, v):
    b, s = q.shape[0], q.shape[1]
    nblk = s // Q_BLOCK
    scale = HEAD_DIM ** -0.5
    qb = q.reshape(b, nblk, Q_BLOCK, N_KV_HEADS, GQA_GROUP, HEAD_DIM).transpose(1, 0, 2, 3, 4, 5)

    def one_block(qblk):
        sc = jnp.einsum('bqgrd,bkgd->bgrqk', qblk, k).astype(jnp.float32) * scale
        p = jax.nn.softmax(sc, axis=-1).astype(v.dtype)
        return jnp.einsum('bgrqk,bkgd->bqgrd', p, v)

    out = lax.map(one_block, qb)
    return out.transpose(1, 0, 2, 3, 4, 5).reshape(b, s, ATTN_W)


def _spatial_gating(u, v, g_v, w_s, b_s):
    b, s = u.shape[0], u.shape[1]
    nchunk = s // SG_CHUNK
    vn = _rmsnorm(v, g_v).reshape(b, nchunk, SG_CHUNK, N_SG_HEADS, HEAD_DIM)
    mixed = jnp.einsum('hpq,bnqhc->bnphc', w_s, vn) + b_s.T[:, :, None]
    return u * mixed.reshape(b, s, SG_W)


def setup_inputs(seed: int = 0) -> dict:
    key = jax.random.key(seed)
    ks = jax.random.split(key, 16)
    f32 = jnp.float32
    nrm = lambda k, shape, s: jax.random.normal(k, shape, f32) * s
    res_scale = (2.0 * DEPTH) ** -0.5
    return {
        "x": jax.random.normal(ks[0], (BATCH, SEQ, D_MODEL), f32),
        "norm1_g": 1.0 + nrm(ks[1], (DEPTH, D_MODEL), 0.02),
        "w_in": nrm(ks[2], (DEPTH, D_MODEL, PROJ_W), D_MODEL ** -0.5),
        "q_norm_g": 1.0 + nrm(ks[3], (DEPTH, HEAD_DIM), 0.02),
        "k_norm_g": 1.0 + nrm(ks[4], (DEPTH, HEAD_DIM), 0.02),
        "sg_norm_g": 1.0 + nrm(ks[5], (DEPTH, SG_W), 0.02),
        "sg_w": nrm(ks[6], (DEPTH, N_SG_HEADS, SG_CHUNK, SG_CHUNK), 0.5 * SG_CHUNK ** -0.5),
        "sg_b": 1.0 + nrm(ks[7], (DEPTH, N_SG_HEADS, SG_CHUNK), 0.1),
        "conv_w": nrm(ks[8], (DEPTH, CONV_K, CONV_W), CONV_K ** -0.5),
        "w_out": nrm(ks[9], (DEPTH, D_MIX, D_MODEL), D_MIX ** -0.5 * res_scale),
        "norm2_g": 1.0 + nrm(ks[10], (DEPTH, D_MODEL), 0.02),
        "ffn_w_up": nrm(ks[11], (DEPTH, D_MODEL, 2 * D_FF), D_MODEL ** -0.5),
        "ffn_conv_w": nrm(ks[12], (DEPTH, CONV_K, 2 * D_FF), CONV_K ** -0.5),
        "ffn_w_down": nrm(ks[13], (DEPTH, D_FF, D_MODEL), D_FF ** -0.5 * res_scale),
    }


def reference(x, norm1_g, w_in, q_norm_g, k_norm_g, sg_norm_g, sg_w, sg_b, conv_w,
              w_out, norm2_g, ffn_w_up, ffn_conv_w, ffn_w_down):
    b, s, _ = x.shape
    ang_r, ang_c = _axial_angles(s)
    dt = x.dtype
    tabs = (jnp.cos(ang_r)[:, None, :].astype(dt), jnp.sin(ang_r)[:, None, :].astype(dt),
            jnp.cos(ang_c)[:, None, :].astype(dt), jnp.sin(ang_c)[:, None, :].astype(dt))
    split_at = np.cumsum(PROJ_SPLITS)[:-1].tolist()

    for l in range(DEPTH):
        h = _rmsnorm(x, norm1_g[l])
        p = h @ w_in[l]
        q, k, v, su, sv, cb, cc, cx = jnp.split(p, split_at, axis=-1)

        q = _rmsnorm(q.reshape(b, s, N_Q_HEADS, HEAD_DIM), q_norm_g[l])
        k = _rmsnorm(k.reshape(b, s, N_KV_HEADS, HEAD_DIM), k_norm_g[l])
        q = _axial_rope(q, tabs)
        k = _axial_rope(k, tabs)
        a_out = _block_attention(q, k, v.reshape(b, s, N_KV_HEADS, HEAD_DIM))

        g_out = _spatial_gating(su, sv, sg_norm_g[l], sg_w[l], sg_b[l])

        c_out = cb * _dwconv3(cc * cx, conv_w[l])

        mix = jnp.concatenate([a_out, g_out, c_out], axis=-1)
        x = x + mix @ w_out[l]

        h2 = _rmsnorm(x, norm2_g[l])
        up = _dwconv3(h2 @ ffn_w_up[l], ffn_conv_w[l])
        gate, val = jnp.split(up, 2, axis=-1)
        x = x + (jax.nn.silu(gate) * val) @ ffn_w_down[l]
    return x
```

```cpp
#include <hip/hip_runtime.h>
#include <hip/hip_cooperative_groups.h>
#include <hip/hip_bf16.h>
#include <cstdio>
#include <cstdint>
#include <cmath>
namespace cg = cooperative_groups;
namespace pg8 {
#define PG8_LAS __attribute__((address_space(3)))
typedef unsigned short bf16_t;
typedef short bf16x8 __attribute__((ext_vector_type(8)));
typedef float f32x4 __attribute__((ext_vector_type(4)));
typedef unsigned u32x4 __attribute__((ext_vector_type(4)));
typedef unsigned u32x2 __attribute__((ext_vector_type(2)));
constexpr int BM = 256, BK = 64, HALF = 128, HTB = HALF * BK * 2  , STAGE_BYTES = 8 * HTB, NXCD = 8, WGM = 8;

__host__ __device__ __forceinline__ int lds_byte(int r, int c) { const int st = (r >> 4) * 2 + (c >> 5), rr = r & 15, cc = c & 31, ob = rr * 64 + cc * 2; return st * 1024 + (ob ^ (((ob >> 9) & 1) << 5)); }
__host__ __device__ __forceinline__ void stage_rc(int b, int& R, int& C) { const int st = b / 1024, sb = b % 1024, swz = sb ^ (((sb >> 9) & 1) << 5); R = (st >> 1) * 16 + swz / 64; C = (st & 1) * 32 + (swz % 64) / 2; }
__host__ __device__ __forceinline__ int perm32(int rho) { const int n = rho >> 4, i = rho & 15; return 8 * (i >> 2) + 4 * n + (i & 3); }

struct Unit { int pm, pn, slot; };
struct Gemm { const bf16_t* A; const bf16_t* Bt; int M, N, K; };

struct StaticOrder;
__device__ __forceinline__ void rstd_table_hook(const float* part, const StaticOrder& S, int tid);
struct StaticOrder {
    int nM, nN, nwg, G, c; const float* tbl_part = nullptr;
    __device__ __forceinline__ void after_issue(int tid) const { if (tbl_part) rstd_table_hook(tbl_part, *this, tid); }
    __host__ __device__ __forceinline__ void init(int M, int N, int G_, int c_) { nM = M / BM; nN = N / BM; nwg = nM * nN; G = G_; c = c_; }
    __host__ __device__ __forceinline__ bool next(int i, Unit& u) const {
        const long L = (long)i * G + c; if (L >= nwg) return false;
        int wgid = (int)L; { const int q = nwg / NXCD, r = nwg % NXCD, xcd = wgid % NXCD, off = wgid / NXCD; wgid = (xcd < r ? xcd * (q + 1) : r * (q + 1) + (xcd - r) * q) + off; }
        const int nig = WGM * nN, gid = wgid / nig, fm = gid * WGM, gsz = (nM - fm) < WGM ? (nM - fm) : WGM;
        u.pm = fm + ((wgid % nig) % gsz); u.pn = (wgid % nig) / gsz; u.slot = i; return true;
    }
    __device__ __forceinline__ void a_ready(const Unit&) const {}
    __device__ __forceinline__ void done(const Unit&) const {}
};

__device__ __forceinline__ unsigned cvt_pk_bf16(float lo, float hi) { unsigned r; asm volatile("v_cvt_pk_bf16_f32 %0, %1, %2" : "=v"(r) : "v"(lo), "v"(hi)); return r; }
typedef float f32x2 __attribute__((ext_vector_type(2)));
constexpr float RMS_EPS = 1e-6f;
constexpr int RSTD_TBL_OFF = 131072 + 1024 + 8192;
struct EpiScaleBf16 {
    static constexpr bool PERM = true, AFTER_DRAIN = false;
    bf16_t* O; int ldc;
    __device__ __forceinline__ void operator()(f32x4 (&acc)[2][2][4][2], const Unit& u, int wr, int wc, int fr, int fq) const {
        const int row0 = u.pm * BM + wr * 64 + fr, col0 = u.pn * BM + wc * 32 + 8 * fq;
        const PG8_LAS float* rsT = (const PG8_LAS float*)RSTD_TBL_OFF + u.slot * 256 + wr * 64 + fr;
        typedef __attribute__((address_space(1))) u32x4 gu32x4;
#pragma unroll
        for (int ai = 0; ai < 2; ++ai)
#pragma unroll
            for (int m = 0; m < 4; ++m) {
                const int r = row0 + ai * HALF + m * 16;
                const float rs = rsT[ai * HALF + m * 16];
                bf16_t* rowp = O + (size_t)r * ldc + col0;
#pragma unroll
                for (int bj = 0; bj < 2; ++bj) { const f32x4 v0 = acc[ai][bj][m][0] * rs, v1 = acc[ai][bj][m][1] * rs;
                    u32x4 w; w.x = cvt_pk_bf16(v0[0], v0[1]); w.y = cvt_pk_bf16(v0[2], v0[3]); w.z = cvt_pk_bf16(v1[0], v1[1]); w.w = cvt_pk_bf16(v1[2], v1[3]);
                    *(gu32x4*)(rowp + bj * HALF) = w; }
            }
    }
};
__device__ __forceinline__ void rstd_table_hook(const float* part, const StaticOrder& S, int tid) {
    PG8_LAS float* tbl = (PG8_LAS float*)RSTD_TBL_OFF; Unit u;
    for (int i = 0; i < 8 && S.next(i, u); ++i)
        if (tid < 256) { const f32x4* pp = (const f32x4*)(part + (size_t)(u.pm * 256 + tid) * 16);
            const f32x4 p0 = pp[0], p1 = pp[1], p2 = pp[2], p3 = pp[3]; const f32x4 ps = (p0 + p1) + (p2 + p3);
            tbl[i * 256 + tid] = __builtin_amdgcn_rsqf(((ps[0] + ps[1]) + (ps[2] + ps[3])) * (1.0f / 1024.0f) + RMS_EPS); asm volatile("" ::: "memory"); }
}
__device__ __forceinline__ float lane_xor32(float v) { const unsigned b = __float_as_uint(v); auto rr = __builtin_amdgcn_permlane32_swap(b, b, false, false); return __uint_as_float(rr[0] ^ rr[1] ^ b); }
struct EpiInProj {
    static constexpr bool PERM = true, AFTER_DRAIN = false;
    bf16_t* O; int ldc; bf16_t* kimg; bf16_t* vimg; const float* gk;
    __device__ __forceinline__ void operator()(f32x4 (&acc)[2][2][4][2], const Unit& u, int wr, int wc, int fr, int fq) const {
        const int row0 = u.pm * BM + wr * 64 + fr;
        const PG8_LAS float* rsT = (const PG8_LAS float*)RSTD_TBL_OFF + u.slot * 256 + wr * 64 + fr;
        typedef __attribute__((address_space(1))) u32x4 gu32x4;
        if (u.pn != 2) {
            const int col0 = u.pn * BM + wc * 32 + 8 * fq;
#pragma unroll
            for (int ai = 0; ai < 2; ++ai)
#pragma unroll
                for (int m = 0; m < 4; ++m) {
                    const int r = row0 + ai * HALF + m * 16;
                    const float rs = rsT[ai * HALF + m * 16];
                    bf16_t* rowp = O + (size_t)r * ldc + col0;
#pragma unroll
                    for (int bj = 0; bj < 2; ++bj) { const f32x4 v0 = acc[ai][bj][m][0] * rs, v1 = acc[ai][bj][m][1] * rs;
                        u32x4 w; w.x = cvt_pk_bf16(v0[0], v0[1]); w.y = cvt_pk_bf16(v0[2], v0[3]); w.z = cvt_pk_bf16(v1[0], v1[1]); w.w = cvt_pk_bf16(v1[2], v1[3]);
                        *(gu32x4*)(rowp + bj * HALF) = w; }
                }
            return;
        }
        { int ln = threadIdx.x; asm volatile("" : "+v"(ln)); fr = ln & 15; fq = (ln >> 4) & 3; }
        const int row0k = u.pm * BM + wr * 64 + fr; const PG8_LAS float* rsTk = (const PG8_LAS float*)RSTD_TBL_OFF + u.slot * 256 + wr * 64 + fr;
        const bool isk = wc < 2; const int kvh = wc & 1;
        float inv[8], gg[2][8];
#pragma unroll
        for (int e = 0; e < 8; ++e) { inv[e] = __builtin_amdgcn_exp2f(-(float)(8 * (fq & 1) + e) * (13.287712379549449f / 16.0f)); gg[0][e] = gk[8 * fq + e]; gg[1][e] = gk[32 + 8 * fq + e]; }
        const float sgn = (fq & 2) ? 1.0f : -1.0f;
#pragma unroll
        for (int ai = 0; ai < 2; ++ai) {
            float crow[8], srow[8];
            if (isk) { const float prow = (float)(((row0k + ai * HALF) & 8191) >> 6);
#pragma unroll
                for (int e = 0; e < 8; ++e) { const float ang = prow * inv[e]; crow[e] = __cosf(ang); srow[e] = __sinf(ang); } }
#pragma unroll
            for (int m = 0; m < 4; ++m) {
                const int r = row0k + ai * HALF + m * 16, t = r & 8191, bb = r >> 13, tile = t >> 6, r6 = t & 63;
                const float rs = rsTk[ai * HALF + m * 16];
                float x[2][8]; float ss = 0.f;
#pragma unroll
                for (int bj = 0; bj < 2; ++bj)
#pragma unroll
                    for (int e = 0; e < 8; ++e) { x[bj][e] = acc[ai][bj][m][e >> 2][e & 3] * rs; ss += x[bj][e] * x[bj][e]; }
                const size_t img = ((size_t)(bb * 2 + kvh) * 128 + tile) * 4096;
                if (isk) {
                    ss += __shfl_xor(ss, 16); ss += lane_xor32(ss);
                    const float rk = __builtin_amdgcn_rsqf(ss * (1.0f / 64.0f) + RMS_EPS);
#pragma unroll
                    for (int bj = 0; bj < 2; ++bj) {
                        const float pos = (float)(bj == 0 ? (t >> 6) : (t & 63));
                        float o[8];
#pragma unroll
                        for (int e = 0; e < 8; ++e) {
                            const float xn = x[bj][e] * rk * gg[bj][e];
                            const float other = lane_xor32(xn);
                            float c, sn;
                            if (bj == 0) { c = crow[e]; sn = srow[e]; } else { const float ang = pos * inv[e]; c = __cosf(ang); sn = __sinf(ang); }
                            o[e] = xn * c + sgn * other * sn;
                        }
                        u32x4 w; w.x = cvt_pk_bf16(o[0], o[1]); w.y = cvt_pk_bf16(o[2], o[3]); w.z = cvt_pk_bf16(o[4], o[5]); w.w = cvt_pk_bf16(o[6], o[7]);
                        *(gu32x4*)(kimg + img + (4 * bj + fq) * 512 + r6 * 8) = w;
                    }
                } else {
#pragma unroll
                    for (int bj = 0; bj < 2; ++bj) {
                        u32x4 w; w.x = cvt_pk_bf16(x[bj][0], x[bj][1]); w.y = cvt_pk_bf16(x[bj][2], x[bj][3]); w.z = cvt_pk_bf16(x[bj][4], x[bj][5]); w.w = cvt_pk_bf16(x[bj][6], x[bj][7]);
                        *(gu32x4*)(vimg + img + (bj * 4 + (r6 >> 4)) * 512 + ((r6 & 15) * 4 + fq) * 8) = w;
                    }
                }
                asm volatile("" ::: "memory"); __builtin_amdgcn_sched_barrier(0);
            }
        }
    }
};
struct EpiResid {
    static constexpr bool PERM = true, AFTER_DRAIN = false;
    bf16_t* xb; float* part; float* out;
    __device__ __forceinline__ void operator()(f32x4 (&acc)[2][2][4][2], const Unit& u, int wr, int wc, int fr, int fq) const {
        const int row0 = u.pm * BM + wr * 64 + fr, col0 = u.pn * BM + wc * 32 + 8 * fq;
        typedef __attribute__((address_space(1))) u32x4 gu32x4; typedef __attribute__((address_space(1))) f32x4 gf32x4;
#pragma unroll
        for (int ai = 0; ai < 2; ++ai)
#pragma unroll
            for (int m = 0; m < 4; ++m) {
                const int r = row0 + ai * HALF + m * 16;
                const size_t off = (size_t)r * 1024 + col0;
                float ss = 0.f;
#pragma unroll
                for (int bj = 0; bj < 2; ++bj) {
                    const u32x4 raw = *(const gu32x4*)(xb + off + bj * HALF);
                    const f32x4 a = (f32x4){__uint_as_float(raw.x << 16), __uint_as_float(raw.x & 0xffff0000u), __uint_as_float(raw.y << 16), __uint_as_float(raw.y & 0xffff0000u)};
                    const f32x4 b = (f32x4){__uint_as_float(raw.z << 16), __uint_as_float(raw.z & 0xffff0000u), __uint_as_float(raw.w << 16), __uint_as_float(raw.w & 0xffff0000u)};
                    const f32x4 v0 = a + acc[ai][bj][m][0], v1 = b + acc[ai][bj][m][1];
                    if (out) { *(gf32x4*)(out + off + bj * HALF) = v0; *(gf32x4*)(out + off + bj * HALF + 4) = v1; }
                    else {
                        u32x4 w; w.x = cvt_pk_bf16(v0[0], v0[1]); w.y = cvt_pk_bf16(v0[2], v0[3]); w.z = cvt_pk_bf16(v1[0], v1[1]); w.w = cvt_pk_bf16(v1[2], v1[3]);
                        *(gu32x4*)(xb + off + bj * HALF) = w;
                        ss += (v0[0] * v0[0] + v0[1] * v0[1]) + (v0[2] * v0[2] + v0[3] * v0[3]) + (v1[0] * v1[0] + v1[1] * v1[1]) + (v1[2] * v1[2] + v1[3] * v1[3]);
                    }
                }
                if (!out) { ss += __shfl_xor(ss, 16); ss += __shfl_xor(ss, 32);
                    if (fq == 0) part[(size_t)r * 16 + u.pn * 4 + wc] = ss; }
                if (m & 1) asm volatile("" ::: "memory");
            }
    }
};
__device__ __forceinline__ float dpp_ror1(float v) { return __builtin_bit_cast(float, __builtin_amdgcn_mov_dpp(__builtin_bit_cast(int, v), 0x121, 0xf, 0xf, true)); }
__device__ __forceinline__ float dpp_rol1(float v) { return __builtin_bit_cast(float, __builtin_amdgcn_mov_dpp(__builtin_bit_cast(int, v), 0x12f, 0xf, 0xf, true)); }
struct EpiConvAct {
    static constexpr bool PERM = true, AFTER_DRAIN = false;
    bf16_t* act; const float* cw; long halo_off;
    __device__ __forceinline__ void operator()(f32x4 (&acc)[2][2][4][2], const Unit& u, int wr, int wc, int fr, int fq) const {
        float* halo = (float*)((char*)act + halo_off); PG8_LAS float* ex = (PG8_LAS float*)(131072 + 1024);
        const int row0 = u.pm * BM + wr * 64 + fr, cl = wc * 32 + 8 * fq;
        typedef __attribute__((address_space(1))) const f32x4 gf32x4;
        const PG8_LAS float* rsT = (const PG8_LAS float*)RSTD_TBL_OFF + u.slot * 256;
#pragma unroll
        for (int ai = 0; ai < 2; ++ai)
#pragma unroll
            for (int m = 0; m < 4; ++m) {
                const float rs = rsT[wr * 64 + fr + ai * HALF + m * 16];
#pragma unroll
                for (int bj = 0; bj < 2; ++bj)
#pragma unroll
                    for (int n = 0; n < 2; ++n) acc[ai][bj][m][n] *= rs;
            }
#pragma unroll
        for (int ai = 0; ai < 2; ++ai) {
            const int gidx = ai * 2 + wr;
            if (fr == 0) {
#pragma unroll
                for (int bj = 0; bj < 2; ++bj)
#pragma unroll
                    for (int n = 0; n < 2; ++n) *(PG8_LAS f32x4*)(ex + (gidx * 2 + 0) * 256 + bj * HALF + cl + 4 * n) = acc[ai][bj][0][n];
            }
            if (fr == 15) {
#pragma unroll
                for (int bj = 0; bj < 2; ++bj)
#pragma unroll
                    for (int n = 0; n < 2; ++n) *(PG8_LAS f32x4*)(ex + (gidx * 2 + 1) * 256 + bj * HALF + cl + 4 * n) = acc[ai][bj][3][n];
            }
        }
        if (wr == 0 && fr < 2) {
#pragma unroll
            for (int bj = 0; bj < 2; ++bj)
#pragma unroll
                for (int n = 0; n < 2; ++n) *(__attribute__((address_space(1))) f32x4*)(halo + (size_t)(u.pm * 4 + fr) * 5632 + u.pn * BM + bj * HALF + cl + 4 * n) = acc[0][bj][0][n];
        }
        if (wr == 1 && fr >= 14) {
#pragma unroll
            for (int bj = 0; bj < 2; ++bj)
#pragma unroll
                for (int n = 0; n < 2; ++n) *(__attribute__((address_space(1))) f32x4*)(halo + (size_t)(u.pm * 4 + 2 + (fr - 14)) * 5632 + u.pn * BM + bj * HALF + cl + 4 * n) = acc[1][bj][3][n];
        }
        asm volatile("s_waitcnt lgkmcnt(0)" ::: "memory"); __builtin_amdgcn_s_barrier(); asm volatile("" ::: "memory");
        const int ccol = u.pn * HALF + cl;
        u32x2 res0[2][4];
#pragma unroll
        for (int n = 0; n < 2; ++n) {
            f32x4 wgt[3][2];
#pragma unroll
            for (int k = 0; k < 3; ++k) { wgt[k][0] = *(gf32x4*)(cw + k * 5632 + ccol + 4 * n); wgt[k][1] = *(gf32x4*)(cw + k * 5632 + 2816 + ccol + 4 * n); }
#pragma unroll
            for (int ai = 0; ai < 2; ++ai) {
                const int gidx = ai * 2 + wr;
                f32x4 top[2], bot[2];
#pragma unroll
                for (int bj = 0; bj < 2; ++bj) {
                    top[bj] = gidx > 0 ? *(const PG8_LAS f32x4*)(ex + ((gidx - 1) * 2 + 1) * 256 + bj * HALF + cl + 4 * n) : (f32x4){0.f, 0.f, 0.f, 0.f};
                    bot[bj] = gidx < 3 ? *(const PG8_LAS f32x4*)(ex + ((gidx + 1) * 2 + 0) * 256 + bj * HALF + cl + 4 * n) : (f32x4){0.f, 0.f, 0.f, 0.f};
                }
#pragma unroll
                for (int m = 0; m < 4; ++m) {
                    f32x2 y[2][2];
#pragma unroll
                    for (int bj = 0; bj < 2; ++bj) {
                        const f32x4 cur = acc[ai][bj][m][n];
#pragma unroll
                        for (int p = 0; p < 2; ++p) {
                            f32x2 prev2, next2, cur2 = (f32x2){cur[2 * p], cur[2 * p + 1]};
#pragma unroll
                            for (int q = 0; q < 2; ++q) { const int j = 2 * p + q;
                                const float pin = dpp_ror1(cur[j]);
                                const float pedge = (m > 0) ? dpp_ror1(acc[ai][bj][m > 0 ? m - 1 : 0][n][j]) : top[bj][j];
                                const float nin = dpp_rol1(cur[j]);
                                const float nedge = (m < 3) ? dpp_rol1(acc[ai][bj][m < 3 ? m + 1 : 3][n][j]) : bot[bj][j];
                                prev2[q] = fr == 0 ? pedge : pin; next2[q] = fr == 15 ? nedge : nin; }
                            const f32x2 w0 = (f32x2){wgt[0][bj][2 * p], wgt[0][bj][2 * p + 1]}, w1 = (f32x2){wgt[1][bj][2 * p], wgt[1][bj][2 * p + 1]}, w2 = (f32x2){wgt[2][bj][2 * p], wgt[2][bj][2 * p + 1]};
                            y[bj][p] = w0 * prev2 + w1 * cur2 + w2 * next2;
                        }
                    }
                    float o[4];
#pragma unroll
                    for (int p = 0; p < 2; ++p) {
                        const f32x2 g = y[0][p], t = g * -1.4426950408889634f;
                        f32x2 e; e[0] = __builtin_amdgcn_exp2f(t[0]); e[1] = __builtin_amdgcn_exp2f(t[1]);
                        const f32x2 d = e + 1.0f;
                        f32x2 r; r[0] = __builtin_amdgcn_rcpf(d[0]); r[1] = __builtin_amdgcn_rcpf(d[1]);
                        const f32x2 o2 = (g * r) * y[1][p];
                        o[2 * p] = o2[0]; o[2 * p + 1] = o2[1];
                    }
                    const int r = row0 + ai * HALF + m * 16;
                    u32x2 w; w.x = cvt_pk_bf16(o[0], o[1]); w.y = cvt_pk_bf16(o[2], o[3]);
                    if (n == 0) res0[ai][m] = w;
                    else { u32x4 w4; w4.x = res0[ai][m].x; w4.y = res0[ai][m].y; w4.z = w.x; w4.w = w.y; *(__attribute__((address_space(1))) u32x4*)(act + (size_t)r * 2816 + ccol) = w4; }
                    asm volatile("" ::: "memory"); __builtin_amdgcn_sched_barrier(0);
                }
            }
        }
    }
};

template <class Epi, class Sched, bool ALIGN_EPI = false, bool SP2 = false>
__device__ __forceinline__ void gemm_phase(PG8_LAS unsigned char* lds, const Gemm g, const Sched& S, const Epi& E, const int tid) {
    const int wid = __builtin_amdgcn_readfirstlane(tid >> 6), lane = tid & 63, wr = wid >> 2, wc = wid & 3, fr = lane & 15, fq = lane >> 4;
    const int K = g.K, nt = K / BK;
    unsigned voffA[2], voffB[2];
#pragma unroll
    for (int i = 0; i < 2; ++i) { int R, C; stage_rc(tid * 16 + i * 8192, R, C); const int Rb = Epi::PERM ? ((R & ~31) + perm32(R & 31)) : R;
        voffA[i] = (unsigned)(R * K + C) * 2u; voffB[i] = (unsigned)(Rb * K + C) * 2u; }
    const size_t kstep = (size_t)(BK * 2);
    const size_t hstep = (size_t)HALF * K * 2;
    const size_t tstep = 2 * hstep;
    const unsigned ldsw = (unsigned)wid * 1024u;
    const int aoff = lds_byte(wr * 64 + fr, fq * 8), boff = lds_byte(wc * 32 + fr, fq * 8);
#define PG8_SA(b, h) (((b) * 2 + (h)) * HTB)
#define PG8_SB(b, h) ((4 + (b) * 2 + (h)) * HTB)
#define PG8_STAGE(bufoff, gbase, voff) do { _Pragma("unroll") for (int _i = 0; _i < 2; ++_i) \
        __builtin_amdgcn_global_load_lds((const unsigned*)((const char*)(gbase) + (voff)[_i]), (PG8_LAS unsigned*)(lds + (bufoff) + ldsw + _i * 8192), 16, 0, 0); } while (0)
#define PG8_LDA(dst, b, h) do { _Pragma("unroll") for (int m = 0; m < 4; ++m) _Pragma("unroll") for (int k = 0; k < 2; ++k) dst[m][k] = *(const PG8_LAS bf16x8*)(lds + PG8_SA(b, h) + aoff + m * 2048 + k * 1024); } while (0)
#define PG8_LDB(dst, b, h) do { _Pragma("unroll") for (int n = 0; n < 2; ++n) _Pragma("unroll") for (int k = 0; k < 2; ++k) dst[n][k] = *(const PG8_LAS bf16x8*)(lds + PG8_SB(b, h) + boff + n * 2048 + k * 1024); } while (0)
#define PG8_MMA(ai, bj, At, Bt) do { __builtin_amdgcn_s_setprio(1); _Pragma("unroll") for (int m = 0; m < 4; ++m) _Pragma("unroll") for (int n = 0; n < 2; ++n) _Pragma("unroll") for (int k = 0; k < 2; ++k) \
        acc[ai][bj][m][n] = __builtin_amdgcn_mfma_f32_16x16x32_bf16(Bt[n][k], At[m][k], acc[ai][bj][m][n], 0, 0, 0); __builtin_amdgcn_s_setprio(0); } while (0)
#define PG8_WAIT_V(n) asm volatile("s_waitcnt vmcnt(" #n ")" ::: "memory")
#define PG8_WAIT_L(n) asm volatile("s_waitcnt lgkmcnt(" #n ")" ::: "memory")
#define PG8_BAR __builtin_amdgcn_s_barrier()
#define PG8_SCHED __builtin_amdgcn_sched_barrier(0)
    Unit cur, nxt; int ui = 0;
    if (!S.next(0, cur)) return;
    f32x4 acc[2][2][4][2];
#pragma unroll
    for (int a = 0; a < 2; ++a)
#pragma unroll
        for (int b = 0; b < 2; ++b)
#pragma unroll
            for (int m = 0; m < 4; ++m)
#pragma unroll
                for (int n = 0; n < 2; ++n) acc[a][b][m][n] = (f32x4){0.f, 0.f, 0.f, 0.f};
    bf16x8 At[4][2], B0[2][2], B1[2][2];
    const char* cA = (const char*)g.A + (size_t)cur.pm * tstep; const char* cB = (const char*)g.Bt + (size_t)cur.pn * tstep;
    S.a_ready(cur);
    if constexpr (SP2) {
        PG8_STAGE(PG8_SB(0, 0), cB, voffB); PG8_STAGE(PG8_SB(0, 1), cB + hstep, voffB); PG8_STAGE(PG8_SA(0, 0), cA, voffA); PG8_STAGE(PG8_SA(0, 1), cA + hstep, voffA);
        S.after_issue(tid);
        if (wr == 1) PG8_BAR;
        PG8_WAIT_V(2); PG8_BAR;
        PG8_STAGE(PG8_SB(1, 0), cB + kstep, voffB); PG8_STAGE(PG8_SA(1, 0), cA + kstep, voffA); PG8_STAGE(PG8_SB(1, 1), cB + hstep + kstep, voffB);
        PG8_WAIT_V(6); PG8_BAR;
    } else {
        PG8_STAGE(PG8_SB(0, 0), cB, voffB); PG8_STAGE(PG8_SA(0, 0), cA, voffA); PG8_STAGE(PG8_SB(0, 1), cB + hstep, voffB); PG8_STAGE(PG8_SA(0, 1), cA + hstep, voffA);
        if (wr == 1) PG8_BAR;
        PG8_WAIT_V(4); PG8_BAR;
        PG8_STAGE(PG8_SB(1, 0), cB + kstep, voffB); PG8_STAGE(PG8_SA(1, 0), cA + kstep, voffA); PG8_STAGE(PG8_SB(1, 1), cB + hstep + kstep, voffB);
        PG8_WAIT_V(6); PG8_BAR;
    }
    for (;;) {
        const bool has_next = S.next(ui + 1, nxt);
        const char* nA = has_next ? (const char*)g.A + (size_t)nxt.pm * tstep : cA; const char* nB = has_next ? (const char*)g.Bt + (size_t)nxt.pn * tstep : cB;
        for (int t = 0; t < nt; t += 2) {
            const bool last = (t == nt - 2);
            const char* a1 = cA + (size_t)(t + 1) * kstep;
            const char* a2 = last ? nA : cA + (size_t)(t + 2) * kstep; const char* b2 = last ? nB : cB + (size_t)(t + 2) * kstep;
            const char* a3 = a2 + kstep; const char* b3 = b2 + kstep;
            if (last && has_next) S.a_ready(nxt);
            if constexpr (SP2) {
            PG8_LDB(B0, 0, 0); PG8_LDB(B1, 0, 1); PG8_SCHED; PG8_LDA(At, 0, 0); PG8_STAGE(PG8_SA(1, 1), a1 + hstep, voffA);
            PG8_WAIT_V(8); PG8_WAIT_L(0); PG8_BAR; PG8_MMA(0, 0, At, B0); PG8_MMA(0, 1, At, B1); PG8_BAR; PG8_SCHED;
            PG8_LDA(At, 0, 1); PG8_STAGE(PG8_SB(0, 0), b2, voffB); PG8_STAGE(PG8_SB(0, 1), b2 + hstep, voffB); PG8_STAGE(PG8_SA(0, 0), a2, voffA);
            PG8_WAIT_V(8); PG8_WAIT_L(0); PG8_BAR; PG8_MMA(1, 0, At, B0); PG8_MMA(1, 1, At, B1); PG8_BAR; PG8_SCHED;
            PG8_LDB(B0, 1, 0); PG8_LDB(B1, 1, 1); PG8_SCHED; PG8_LDA(At, 1, 0); PG8_STAGE(PG8_SA(0, 1), a2 + hstep, voffA);
            PG8_WAIT_V(8); PG8_WAIT_L(0); PG8_BAR; PG8_MMA(0, 0, At, B0); PG8_MMA(0, 1, At, B1); PG8_BAR; PG8_SCHED;
            PG8_LDA(At, 1, 1); PG8_STAGE(PG8_SB(1, 0), b3, voffB); PG8_STAGE(PG8_SB(1, 1), b3 + hstep, voffB); PG8_STAGE(PG8_SA(1, 0), a3, voffA);
            PG8_WAIT_V(8); PG8_WAIT_L(0); PG8_BAR; PG8_MMA(1, 0, At, B0); PG8_MMA(1, 1, At, B1); PG8_BAR; PG8_SCHED;
            } else {
            PG8_LDB(B0, 0, 0); PG8_SCHED; PG8_LDA(At, 0, 0); PG8_STAGE(PG8_SA(1, 1), a1 + hstep, voffA);
            PG8_WAIT_L(8); PG8_BAR; PG8_WAIT_L(0); PG8_MMA(0, 0, At, B0); PG8_BAR; PG8_SCHED;
            PG8_LDB(B1, 0, 1); PG8_STAGE(PG8_SB(0, 0), b2, voffB);
            PG8_BAR; PG8_WAIT_L(0); PG8_MMA(0, 1, At, B1); PG8_BAR;
            PG8_LDA(At, 0, 1); PG8_STAGE(PG8_SA(0, 0), a2, voffA);
            PG8_BAR; PG8_WAIT_L(0); PG8_MMA(1, 0, At, B0); PG8_BAR; PG8_SCHED;
            PG8_STAGE(PG8_SB(0, 1), b2 + hstep, voffB);
            PG8_WAIT_V(6); PG8_BAR; PG8_MMA(1, 1, At, B1); PG8_BAR;
            PG8_LDB(B0, 1, 0); PG8_SCHED; PG8_LDA(At, 1, 0); PG8_STAGE(PG8_SA(0, 1), a2 + hstep, voffA);
            PG8_WAIT_L(8); PG8_BAR; PG8_WAIT_L(0); PG8_MMA(0, 0, At, B0); PG8_BAR; PG8_SCHED;
            PG8_LDB(B1, 1, 1); PG8_STAGE(PG8_SB(1, 0), b3, voffB);
            PG8_BAR; PG8_WAIT_L(0); PG8_MMA(0, 1, At, B1); PG8_BAR;
            PG8_LDA(At, 1, 1); PG8_STAGE(PG8_SA(1, 0), a3, voffA);
            PG8_BAR; PG8_WAIT_L(0); PG8_MMA(1, 0, At, B0); PG8_BAR; PG8_SCHED;
            PG8_STAGE(PG8_SB(1, 1), b3 + hstep, voffB);
            PG8_WAIT_V(6); PG8_BAR; PG8_MMA(1, 1, At, B1); PG8_BAR;
            }
        }
        if constexpr (ALIGN_EPI) { if (wr == 0) PG8_BAR; }
        if constexpr (!Epi::AFTER_DRAIN) { E(acc, cur, wr, wc, fr, fq); S.done(cur); }
        if (!has_next) break;
#pragma unroll
        for (int a = 0; a < 2; ++a)
#pragma unroll
            for (int b = 0; b < 2; ++b)
#pragma unroll
                for (int m = 0; m < 4; ++m)
#pragma unroll
                    for (int n = 0; n < 2; ++n) acc[a][b][m][n] = (f32x4){0.f, 0.f, 0.f, 0.f};
        cur = nxt; cA = nA; cB = nB; ++ui;
        if constexpr (ALIGN_EPI) { if (wr == 1) PG8_BAR; }
    }
    PG8_WAIT_V(0);
    if constexpr (!ALIGN_EPI) { if (wr == 0) PG8_BAR; }
    PG8_BAR;
    if constexpr (Epi::AFTER_DRAIN) { E.fused(acc, cur, wr, wc, fr, fq, lds, wid, lane); S.done(cur); }
#undef PG8_SA
#undef PG8_SB
#undef PG8_STAGE
#undef PG8_LDA
#undef PG8_LDB
#undef PG8_MMA
#undef PG8_WAIT_V
#undef PG8_WAIT_L
#undef PG8_BAR
#undef PG8_SCHED
}
}
namespace attn_body {
using bf16=__hip_bfloat16;
using bf16x8=__attribute__((ext_vector_type(8)))short;
using s16x4=__attribute__((ext_vector_type(4)))short;
using f32x16=__attribute__((ext_vector_type(16)))float;
using u32x4=__attribute__((ext_vector_type(4)))unsigned;
constexpr int BATCH=2,NHEAD=8,SEQ=8192,D=64,QP=2048,KP=128,VP=128,OP=1024;
constexpr int NW=8,QBLK=32,QB=QBLK*NW,KVBLK=64,NQB=SEQ/QB;
constexpr int ATTN_UNIT_ROWS=QB;
__device__ __forceinline__ int crow(int r,int hi){return (r&3)+8*(r>>2)+4*hi;}
#define SBAR() __builtin_amdgcn_sched_barrier(0)
__device__ __forceinline__ void cmask(f32x16&p0,f32x16&p1,int jb,int qrel,int hi){
  const float NEG=-INFINITY; int kb=64*jb+4*hi;
  #pragma unroll
  for(int r=0;r<16;++r){int kv=kb+(r&3)+8*(r>>2); if(kv>qrel)p0[r]=NEG; if(kv+32>qrel)p1[r]=NEG;}
}

constexpr int NSLOT=3, SLOTB=8192;
constexpr int LDS_K=0, LDS_V=NSLOT*SLOTB, LDS_WS=2*NSLOT*SLOTB, LDS_OST=LDS_WS+NW*64*4, LDS_BYTES=LDS_OST+NW*4096;
constexpr float C2=0.125f*1.4426950408889634f;
__device__ __forceinline__ void glds16(const void*gsrc,unsigned lds_dst){unsigned keep;
  asm volatile("s_mov_b32 %0, m0\n\ts_mov_b32 m0, %2\n\ts_nop 0\n\tglobal_load_lds_dwordx4 %1, off\n\ts_mov_b32 m0, %0":"=&s"(keep):"v"(gsrc),"s"(lds_dst):"memory");}
__device__ __forceinline__ float max3f(float a,float b,float c){float r;asm("v_max3_f32 %0, %1, %2, %3":"=v"(r):"v"(a),"v"(b),"v"(c));return r;}
__device__ __forceinline__ float max2f(float a,float b){float r;asm("v_max_f32_e32 %0, %1, %2":"=v"(r):"v"(a),"v"(b));return r;}
__device__ __forceinline__ float fadd_s(float a,float b){float r;asm("v_add_f32_e32 %0, %1, %2":"=v"(r):"v"(a),"v"(b));return r;}
__device__ __forceinline__ float fsub_s(float a,float b){float r;asm("v_sub_f32_e32 %0, %1, %2":"=v"(r):"v"(a),"v"(b));return r;}
typedef float f32x2_t __attribute__((ext_vector_type(2))); typedef __bf16 bf16x2_t __attribute__((ext_vector_type(2)));
__device__ __forceinline__ unsigned cvtpk_s(float lo,float hi){f32x2_t v={lo,hi};bf16x2_t b=__builtin_convertvector(v,bf16x2_t);return __builtin_bit_cast(unsigned,b);}
#define WAIT_BAR(N) asm volatile("s_waitcnt vmcnt(" #N ") lgkmcnt(0)\n\ts_barrier":::"memory")

__device__ __forceinline__ void qkt(f32x16&p0,f32x16&p1,const char*Kslot,const bf16x8*qr,const f32x16&negm,int r32,int hi){
  const char*kb=Kslot+hi*1024+r32*16;
  #pragma unroll
  for(int d0=0;d0<4;++d0){
    const bf16x8 b0=*reinterpret_cast<const bf16x8*>(kb+d0*2048);
    const bf16x8 b1=*reinterpret_cast<const bf16x8*>(kb+d0*2048+512);
    if(d0==0){p0=__builtin_amdgcn_mfma_f32_32x32x16_bf16(b0,qr[0],negm,0,0,0);p1=__builtin_amdgcn_mfma_f32_32x32x16_bf16(b1,qr[0],negm,0,0,0);}
    else{p0=__builtin_amdgcn_mfma_f32_32x32x16_bf16(b0,qr[d0],p0,0,0,0);p1=__builtin_amdgcn_mfma_f32_32x32x16_bf16(b1,qr[d0],p1,0,0,0);}}
}
typedef __attribute__((address_space(3))) const char* lds_cptr;
typedef short v4i16_t __attribute__((ext_vector_type(4)));
__device__ __forceinline__ void kload8(bf16x8*kf,lds_cptr kp){
  kf[0]=*(const __attribute__((address_space(3))) bf16x8*)(kp);      kf[1]=*(const __attribute__((address_space(3))) bf16x8*)(kp+512);
  kf[2]=*(const __attribute__((address_space(3))) bf16x8*)(kp+2048); kf[3]=*(const __attribute__((address_space(3))) bf16x8*)(kp+2560);
  kf[4]=*(const __attribute__((address_space(3))) bf16x8*)(kp+4096); kf[5]=*(const __attribute__((address_space(3))) bf16x8*)(kp+4608);
  kf[6]=*(const __attribute__((address_space(3))) bf16x8*)(kp+6144); kf[7]=*(const __attribute__((address_space(3))) bf16x8*)(kp+6656);
}
__device__ __forceinline__ void kload2(bf16x8*kf,lds_cptr kp,int j){ kf[2*j]=*(const __attribute__((address_space(3))) bf16x8*)(kp+j*2048); kf[2*j+1]=*(const __attribute__((address_space(3))) bf16x8*)(kp+j*2048+512); }
__device__ __forceinline__ s16x4 vtr(lds_cptr p){ return __builtin_bit_cast(s16x4,__builtin_amdgcn_ds_read_tr16_b64_v4i16((__attribute__((address_space(3))) v4i16_t*)p)); }
__device__ __forceinline__ float rowmax(const f32x16&p0,const f32x16&p1){
  float a=max3f(p0[0],p0[1],p1[0]),b=max3f(p0[2],p0[3],p1[1]);a=max3f(a,p1[2],p1[3]);
  #pragma unroll
  for(int r=4;r<16;r+=4){a=max3f(a,p0[r],p0[r+1]);b=max3f(b,p0[r+2],p0[r+3]);a=max3f(a,p1[r],p1[r+1]);b=max3f(b,p1[r+2],p1[r+3]);}
  const float m=max2f(a,b);
  auto rr=__builtin_amdgcn_permlane32_swap(__float_as_uint(m),__float_as_uint(m),false,false);
  return max2f(__uint_as_float(rr[0]),__uint_as_float(rr[1]));
}
__device__ __forceinline__ void pv(f32x16*o,int vb,bf16x8 pa0,bf16x8 pa1,bf16x8 pa2,bf16x8 pa3){
  #pragma unroll
  for(int d0=0;d0<2;++d0){s16x4 lo[4],hi[4];
    #pragma unroll
    for(int ks=0;ks<4;++ks){
      asm volatile("ds_read_b64_tr_b16 %0,%1 offset:%c2":"=&v"(lo[ks]):"v"(vb),"i"(d0*4096+ks*1024):"memory");
      asm volatile("ds_read_b64_tr_b16 %0,%1 offset:%c2":"=&v"(hi[ks]):"v"(vb),"i"(d0*4096+ks*1024+512):"memory");}
    asm volatile("s_waitcnt lgkmcnt(0)":::"memory");SBAR();
    #define PK(k) (bf16x8){lo[k][0],lo[k][1],lo[k][2],lo[k][3],hi[k][0],hi[k][1],hi[k][2],hi[k][3]}
    o[d0]=__builtin_amdgcn_mfma_f32_32x32x16_bf16(pa0,PK(0),o[d0],0,0,0);
    o[d0]=__builtin_amdgcn_mfma_f32_32x32x16_bf16(pa1,PK(1),o[d0],0,0,0);
    o[d0]=__builtin_amdgcn_mfma_f32_32x32x16_bf16(pa2,PK(2),o[d0],0,0,0);
    o[d0]=__builtin_amdgcn_mfma_f32_32x32x16_bf16(pa3,PK(3),o[d0],0,0,0);
    #undef PK
  }
}

#ifndef ATTN_STORE16
#define ATTN_STORE16(p,v) (*(u32x4*)(p)=(v))
#endif
template<int THRL,bool TRACK> __device__ __forceinline__ void attn_unit(int b,int h,int kvh,int qb,const bf16*Q,const bf16*__restrict__ K,const bf16*__restrict__ V,bf16*O,const float*gq,char*shm,const int tid){
  const int lane=tid&63,r32=lane&31,hi=lane>>5; const int wid=__builtin_amdgcn_readfirstlane(tid>>6);
  const long rowbase=(long)b*SEQ; const int q0=qb*QB;
  const bf16*Qw=Q+(rowbase+q0+wid*QBLK)*QP+h*D;
  const bf16*Kh=K+(long)(b*2+kvh)*(SEQ/KVBLK)*4096,*Vh=V+(long)(b*2+kvh)*(SEQ/KVBLK)*4096;
  const unsigned lds0=(unsigned)(uintptr_t)shm;
  float*wsf=(float*)(shm+LDS_WS)+wid*64;
  const bf16*ksrc=Kh+wid*512+lane*8;
  const bf16*vsrc=Vh+wid*512+lane*8;
  const unsigned kdst=lds0+LDS_K+wid*1024, vdst=lds0+LDS_V+wid*1024;
  #define DMA_K(t,slot) glds16(ksrc+(long)(t)*4096,(unsigned)__builtin_amdgcn_readfirstlane(kdst+(slot)))
  #define DMA_V(t,slot) glds16(vsrc+(long)(t)*4096,(unsigned)__builtin_amdgcn_readfirstlane(vdst+(slot)))
  const int vb0=(int)(lds0+LDS_V)+((lane>>4)&1)*32+(lane&3)*8+(4*hi+((lane&15)>>2))*64;
  const char*Kbase=shm+LDS_K; bf16x8 kf[8];
  const lds_cptr shm3=(lds_cptr)shm; const lds_cptr kp0=shm3+LDS_K+hi*1024+r32*16; const lds_cptr vp0=shm3+LDS_V+((lane>>4)&1)*32+(lane&3)*8+(4*hi+((lane&15)>>2))*64;
  const int NT=SEQ/KVBLK;
  DMA_K(0,0);DMA_V(0,0);DMA_K(1,SLOTB);
  bf16x8 qr[4];
  { u32x4 raw[4];
    #pragma unroll
    for(int d0=0;d0<4;++d0)raw[d0]=*reinterpret_cast<const u32x4*>(&Qw[(long)r32*QP+d0*16+hi*8]);
    float ss=0.f;
    #pragma unroll
    for(int d0=0;d0<4;++d0){
      #pragma unroll
      for(int w=0;w<4;++w){ const float lo=__uint_as_float(raw[d0][w]<<16), hh=__uint_as_float(raw[d0][w]&0xffff0000u); ss+=lo*lo+hh*hh; } }
    { auto rr=__builtin_amdgcn_permlane32_swap(__float_as_uint(ss),__float_as_uint(ss),false,false); ss=__uint_as_float(rr[0])+__uint_as_float(rr[1]); }
    const float rs=__builtin_amdgcn_rsqf(ss*(1.0f/64.0f)+1e-6f)*C2;
    const int tq=q0+wid*QBLK+r32;
    #pragma unroll
    for(int part=0;part<2;++part){
      const float pos=(float)(part==0?(tq>>6):(tq&63));
      float y0[8],y1[8];
      #pragma unroll
      for(int e=0;e<8;++e){
        const float inv=__builtin_amdgcn_exp2f(-(float)(8*hi+e)*(13.287712379549449f/16.0f));
        const float ang=pos*inv; const float c=__cosf(ang), sn=__sinf(ang);
        const unsigned w0=raw[2*part][e>>1], w1=raw[2*part+1][e>>1];
        const float a0=((e&1)?__uint_as_float(w0&0xffff0000u):__uint_as_float(w0<<16))*rs*gq[32*part+8*hi+e];
        const float a1=((e&1)?__uint_as_float(w1&0xffff0000u):__uint_as_float(w1<<16))*rs*gq[32*part+16+8*hi+e];
        y0[e]=a0*c-a1*sn; y1[e]=a0*sn+a1*c; }
      u32x4 wa,wb;
      #pragma unroll
      for(int w=0;w<4;++w){ wa[w]=cvtpk_s(y0[2*w],y0[2*w+1]); wb[w]=cvtpk_s(y1[2*w],y1[2*w+1]); }
      qr[2*part]=__builtin_bit_cast(bf16x8,wa); qr[2*part+1]=__builtin_bit_cast(bf16x8,wb);
      asm volatile("":"+v"(qr[2*part]),"+v"(qr[2*part+1])); SBAR(); } }
  float mhat=0.f,l_reg=0.f;f32x16 o[2],negm; { float zf=0.f; asm volatile("":"+v"(zf));
    _Pragma("unroll") for(int r=0;r<16;++r){o[0][r]=zf;o[1][r]=zf;negm[r]=zf;} } asm volatile("":"+v"(negm));

  #define CMASK(P0,P1,t) do{}while(0)
  bool resc=false;
  #define START(P0,P1) do{ const float rm=rowmax(P0,P1); resc=false; \
    { const float dl=rm; mhat=fadd_s(mhat,dl); \
      _Pragma("unroll") for(int r=0;r<16;++r){P0[r]=fsub_s(P0[r],dl);P1[r]=fsub_s(P1[r],dl);} \
      _Pragma("unroll") for(int r=0;r<16;++r)negm[r]=-mhat; asm volatile("":"+v"(negm)); } \
    _Pragma("unroll") for(int r=0;r<16;++r)P0[r]=__builtin_amdgcn_exp2f(P0[r]); }while(0)
  #define RESC() do{ if(resc){ asm volatile("s_waitcnt lgkmcnt(0)":::"memory"); \
      _Pragma("unroll") for(int d_=0;d_<2;++d_) _Pragma("unroll") for(int r=0;r<16;++r)o[d_][r]*=wsf[crow(r,hi)]; } }while(0)
  f32x16 pA0,pA1,pB0,pB1;
  int sl_prev=0,sl_cur=0,sl_next=SLOTB;
  #define ROT() do{sl_prev=sl_cur;sl_cur=sl_next;sl_next=(sl_next==(NSLOT-1)*SLOTB)?0:sl_next+SLOTB;}while(0)
  DMA_K(2,2*SLOTB);
  WAIT_BAR(3);
  qkt(pA0,pA1,Kbase,qr,negm,r32,hi);asm volatile("s_nop 15\n\ts_nop 7":"+v"(pA0),"+v"(pA1));CMASK(pA0,pA1,0);
  START(pA0,pA1);
  _Pragma("unroll") for(int r=0;r<16;++r)pA1[r]=__builtin_amdgcn_exp2f(pA1[r]);
  WAIT_BAR(0);
  DMA_K(3,0);DMA_V(1,SLOTB);
  ROT();
  kload8(kf,kp0+sl_cur);
  WAIT_BAR(2);
  s16x4 vlo[8],vhi[8]; u32x4 pw0,pw1,pw2,pw3;
  #define PKW(P,B) cvtpk_s(P[B],P[B+1])
  #define PAF(k) __builtin_bit_cast(bf16x8,pw##k)
  #define VFR(i) (bf16x8){vlo[i][0],vlo[i][1],vlo[i][2],vlo[i][3],vhi[i][0],vhi[i][1],vhi[i][2],vhi[i][3]}
  #define PIN(x) asm volatile("":"+v"(x))
  #define MX3(a,b,c) __builtin_fmaxf(__builtin_fmaxf((a),(b)),(c))
  #define GAPA(MF,A0,A1,A2,A3,W0,W1,PW) do{ MF; sacc+=A0; sacc+=A1; sacc+=A2; sacc+=A3; PIN(sacc); W0; W1; PIN(PW); SBAR(); }while(0)
  #define EX(v) __builtin_amdgcn_exp2f(v)
  #define GAPB(MF,X,B) do{ MF; X[B]=EX(X[B]); X[B+1]=EX(X[B+1]); X[B+2]=EX(X[B+2]); X[B+3]=EX(X[B+3]); PIN(X); SBAR(); }while(0)
  #define VRD(i) do{ vlo[i]=vtr(vp_+(((i)>>2)*4096+((i)&3)*1024)); vhi[i]=vtr(vp_+(((i)>>2)*4096+((i)&3)*1024+512)); }while(0)
  #define KRD(G,j) do{ if(G){ kload2(kf,kp0+sl_next,j); SBAR(); } }while(0)
  #define STEP(C0,C1,P0,P1,t,GK,GV,GL) do{ SBAR(); \
    const lds_cptr vp_=vp0+sl_prev; \
    VRD(0); SBAR(); float sacc=(P0[0]+P0[1]); \
    GAPA(C0=__builtin_amdgcn_mfma_f32_32x32x16_bf16(kf[0],qr[0],negm,0,0,0), P0[2],P0[3],P0[4],P0[5],     pw0[0]=PKW(P0,0), pw0[1]=PKW(P0,2), pw0); \
    VRD(4); SBAR(); GAPA(C1=__builtin_amdgcn_mfma_f32_32x32x16_bf16(kf[1],qr[0],negm,0,0,0), P0[6],P0[7],P0[8],P0[9],     pw0[2]=PKW(P0,4), pw0[3]=PKW(P0,6), pw0); \
    VRD(1); SBAR(); GAPA(C0=__builtin_amdgcn_mfma_f32_32x32x16_bf16(kf[2],qr[1],C0,0,0,0),   P0[10],P0[11],P0[12],P0[13], pw1[0]=PKW(P0,8), pw1[1]=PKW(P0,10), pw1); \
    VRD(5); SBAR(); GAPA(C1=__builtin_amdgcn_mfma_f32_32x32x16_bf16(kf[3],qr[1],C1,0,0,0),   P0[14],P0[15],P1[0],P1[1],   pw1[2]=PKW(P0,12),pw1[3]=PKW(P0,14), pw1); \
    VRD(2); SBAR(); GAPA(C0=__builtin_amdgcn_mfma_f32_32x32x16_bf16(kf[4],qr[2],C0,0,0,0),   P1[2],P1[3],P1[4],P1[5],     pw2[0]=PKW(P1,0), pw2[1]=PKW(P1,2), pw2); \
    VRD(6); SBAR(); GAPA(C1=__builtin_amdgcn_mfma_f32_32x32x16_bf16(kf[5],qr[2],C1,0,0,0),   P1[6],P1[7],P1[8],P1[9],     pw2[2]=PKW(P1,4), pw2[3]=PKW(P1,6), pw2); \
    VRD(3); SBAR(); GAPA(C0=__builtin_amdgcn_mfma_f32_32x32x16_bf16(kf[6],qr[3],C0,0,0,0),   P1[10],P1[11],P1[12],P1[13], pw3[0]=PKW(P1,8), pw3[1]=PKW(P1,10), pw3); \
    VRD(7); SBAR(); GAPA(C1=__builtin_amdgcn_mfma_f32_32x32x16_bf16(kf[7],qr[3],C1,0,0,0),   P1[14],P1[15],0.f,0.f,       pw3[2]=PKW(P1,12),pw3[3]=PKW(P1,14), pw3); \
    l_reg+=sacc; \
    if(GK){DMA_K((t)+3,sl_cur);} if(GV){DMA_V((t)+1,sl_next);} \
    CMASK(C0,C1,t); \
    if(TRACK){ float a=MX3(C0[0],C0[1],C1[0]),b=MX3(C0[2],C0[3],C1[1]); a=MX3(a,C1[2],C1[3]); \
      _Pragma("unroll") for(int r=4;r<16;r+=4){a=MX3(a,C0[r],C0[r+1]);b=MX3(b,C0[r+2],C0[r+3]);a=MX3(a,C1[r],C1[r+1]);b=MX3(b,C1[r+2],C1[r+3]);} \
      float rm=__builtin_fmaxf(a,b); { auto rr=__builtin_amdgcn_permlane32_swap(__float_as_uint(rm),__float_as_uint(rm),false,false); rm=__builtin_fmaxf(__uint_as_float(rr[0]),__uint_as_float(rr[1])); } \
      resc=false; \
      if(__builtin_expect(__any(rm>(float)THRL),0)){ const float dl=__builtin_fmaxf(rm,0.f); mhat+=dl; \
        _Pragma("unroll") for(int r=0;r<16;++r){C0[r]-=dl;C1[r]-=dl;} \
        _Pragma("unroll") for(int r=0;r<16;++r)negm[r]=-mhat; asm volatile("":"+v"(negm)); \
        const float f=__builtin_amdgcn_exp2f(-dl); l_reg*=f; if(hi==0)wsf[r32]=f; resc=true; } } \
    SBAR(); \
    GAPB(o[0]=__builtin_amdgcn_mfma_f32_32x32x16_bf16(PAF(0),VFR(0),o[0],0,0,0), C0,0); \
    GAPB(o[1]=__builtin_amdgcn_mfma_f32_32x32x16_bf16(PAF(0),VFR(4),o[1],0,0,0), C0,4); \
    KRD(GL,0); GAPB(o[0]=__builtin_amdgcn_mfma_f32_32x32x16_bf16(PAF(1),VFR(1),o[0],0,0,0), C0,8); \
    KRD(GL,1); GAPB(o[1]=__builtin_amdgcn_mfma_f32_32x32x16_bf16(PAF(1),VFR(5),o[1],0,0,0), C0,12); \
    KRD(GL,2); GAPB(o[0]=__builtin_amdgcn_mfma_f32_32x32x16_bf16(PAF(2),VFR(2),o[0],0,0,0), C1,0); \
    KRD(GL,3); GAPB(o[1]=__builtin_amdgcn_mfma_f32_32x32x16_bf16(PAF(2),VFR(6),o[1],0,0,0), C1,4); \
    GAPB(o[0]=__builtin_amdgcn_mfma_f32_32x32x16_bf16(PAF(3),VFR(3),o[0],0,0,0), C1,8); \
    GAPB(o[1]=__builtin_amdgcn_mfma_f32_32x32x16_bf16(PAF(3),VFR(7),o[1],0,0,0), C1,12); \
    }while(0)
  int t=1;
  #undef CMASK
  #define CMASK(P0,P1,t) do{}while(0)
  for(;t+5<NT;t+=2){
    STEP(pB0,pB1,pA0,pA1,t,true,true,true);     WAIT_BAR(2); RESC(); ROT();
    STEP(pA0,pA1,pB0,pB1,t+1,true,true,true);   WAIT_BAR(2); RESC(); ROT();
  }
  #undef CMASK
  #define CMASK(P0,P1,t) do{}while(0)
  #define ENDW(tt) do{ if((tt)+3<NT){WAIT_BAR(2);} else if((tt)+2<NT){WAIT_BAR(1);} else {WAIT_BAR(0);} }while(0)
  for(;t+1<NT;t+=2){
    STEP(pB0,pB1,pA0,pA1,t,(t+3<NT),(t+1<NT),(t+1<NT));       ENDW(t);   RESC(); ROT();
    STEP(pA0,pA1,pB0,pB1,t+1,(t+4<NT),(t+2<NT),(t+2<NT));     ENDW(t+1); RESC(); ROT();
  }
  STEP(pB0,pB1,pA0,pA1,NT-1,false,false,false); RESC();
  { float sacc=pB0[0]+pB0[1]; _Pragma("unroll") for(int r=2;r<16;++r)sacc+=pB0[r]; _Pragma("unroll") for(int r=0;r<16;++r)sacc+=pB1[r]; l_reg+=sacc;
    pw0=(u32x4){PKW(pB0,0),PKW(pB0,2),PKW(pB0,4),PKW(pB0,6)};pw1=(u32x4){PKW(pB0,8),PKW(pB0,10),PKW(pB0,12),PKW(pB0,14)};pw2=(u32x4){PKW(pB1,0),PKW(pB1,2),PKW(pB1,4),PKW(pB1,6)};pw3=(u32x4){PKW(pB1,8),PKW(pB1,10),PKW(pB1,12),PKW(pB1,14)};
    SBAR(); pv(o,vb0+sl_cur,PAF(0),PAF(1),PAF(2),PAF(3)); }
  #undef PKW
  #undef PAF
  #undef VFR
  #undef PIN
  #undef MX3
  #undef GAPA
  #undef GAPB
  #undef EX
  #undef VRD
  #undef KRD
  #undef STEP
  #undef ENDW
  {auto rr=__builtin_amdgcn_permlane32_swap(__float_as_uint(l_reg),__float_as_uint(l_reg),false,false);l_reg=__uint_as_float(rr[0])+__uint_as_float(rr[1]);}
  if(hi==0)wsf[32+r32]=l_reg;asm volatile("s_waitcnt lgkmcnt(0)":::"memory");
  float rli[16];
  #pragma unroll
  for(int r=0;r<16;++r)rli[r]=__builtin_amdgcn_rcpf(wsf[32+crow(r,hi)]);
  bf16*Ow=O+(rowbase+q0+wid*QBLK)*OP+h*D;
  { bf16*stg=(bf16*)(shm+LDS_OST)+wid*2048;
    #pragma unroll
    for(int r=0;r<16;++r){const int orow=crow(r,hi);
      #pragma unroll
      for(int d0=0;d0<2;++d0)stg[orow*64+d0*32+r32]=__float2bfloat16(o[d0][r]*rli[r]);}
    asm volatile("s_waitcnt lgkmcnt(0)":::"memory");
    #pragma unroll
    for(int i=0;i<4;++i){const int row=i*8+(lane>>3),ch=lane&7; const u32x4 v=*(const u32x4*)(stg+row*64+ch*8); ATTN_STORE16(Ow+(long)row*OP+ch*8,v);} }
  asm volatile("s_waitcnt lgkmcnt(0)\n\ts_barrier":::"memory");
  #undef DMA_K
  #undef DMA_V
  #undef CMASK
  #undef START
  #undef RESC
  #undef ROT
}
constexpr int ATTN_LDS_BYTES=LDS_BYTES;
struct AttnTensors { const bf16* Q; const bf16* K; const bf16* V; bf16* O; const float* gq; };
struct AttnUnit { int b, h, kvh, qb; };
struct StaticOrder {
  int vcu, G;
  __device__ __forceinline__ StaticOrder(int grid,int vcu_):vcu(vcu_),G(grid){}
  __device__ __forceinline__ bool next(int i,AttnUnit&u)const{ const int U=i*G+vcu; if(U>=512)return false; const int grp=(U>>6)&3, idx=(U&63)|((U>>8)<<6);
    u.b=grp>>1; u.kvh=grp&1; u.h=(grp&1)*4+(idx>>5); u.qb=idx&31; return true; }
};
template<class Sched,int THRL,bool TRACK> __device__ __forceinline__ void attn_phase(char*lds,const AttnTensors&T,const Sched&S,const int tid){
  AttnUnit u;
  for(int i=0;S.next(i,u);++i){ attn_unit<THRL,TRACK>(u.b,u.h,u.kvh,u.qb,T.Q,T.K,T.V,T.O,T.gq,lds,tid); }
}
#undef SBAR
#undef WAIT_BAR
}
constexpr int NWAVES = 8;
constexpr int BATCH = 2, SEQ = 8192, DMODEL = 1024, MTOK = BATCH * SEQ, DEPTH = 4;
constexpr int PROJ_W = 2048, D_FF = 2816, D_FF2 = 5632;
constexpr int OFF_Q = 0, OFF_K = 512, OFF_V = 640, OFF_SU = 768, OFF_SV = 1024, OFF_CB = 1280, OFF_CC = 1536, OFF_CX = 1792;
constexpr float EPS = 1e-6f;
constexpr float QSCALE = 0.125f * 1.4426950408889634f;
constexpr size_t MiB = 1u << 20;
constexpr size_t WS_PART1 = 1 * MiB, WS_PART2 = 2 * MiB, WS_SGW = 3 * MiB;
constexpr size_t WS_WSET = 4 * MiB, WSET_BYTES = 23 * MiB;
constexpr size_t WO_WIN = 0, WO_WOUT = 4 * MiB, WO_WUP = 6 * MiB, WO_WDOWN = 17 * MiB;
constexpr size_t WS_XB = 50 * MiB;
constexpr size_t WS_PRAW = 82 * MiB, WS_Q = 146 * MiB, WS_K = 162 * MiB, WS_V = 166 * MiB;
constexpr size_t WS_ACT = 82 * MiB;
constexpr size_t WS_MIX = 170 * MiB;
constexpr size_t WS_HALO = 202 * MiB;
constexpr size_t WS_END = 208 * MiB;
constexpr int LDS_BYTES = 153600;

#define LAS __attribute__((address_space(3)))
typedef unsigned short bf16;
typedef unsigned u32x4 __attribute__((ext_vector_type(4)));
typedef unsigned u32x2 __attribute__((ext_vector_type(2)));
typedef float f32x4 __attribute__((ext_vector_type(4)));
typedef short bf16x8 __attribute__((ext_vector_type(8)));

__device__ __forceinline__ unsigned pk2(float lo, float hi) { return pg8::cvt_pk_bf16(lo, hi); }
__device__ __forceinline__ float bf_lo(unsigned u) { return __uint_as_float(u << 16); }
__device__ __forceinline__ float bf_hi(unsigned u) { return __uint_as_float(u & 0xffff0000u); }
__device__ __forceinline__ float wave_sum(float v) {
#pragma unroll
    for (int o = 1; o < 64; o <<= 1) v += __shfl_xor(v, o);
    return v;
}
__device__ __forceinline__ int perm_up(int c) { const int v = c >= D_FF ? 1 : 0, cc = c - v * D_FF; return ((cc >> 7) << 8) + v * 128 + (cc & 127); }
__device__ __forceinline__ int perm_in(int c) { if (c < 512 || c >= 768) return c; const int oc = c - 512, hl = oc >> 6, d = oc & 63; return 512 + (d >> 5) * 128 + hl * 32 + (d & 31); }
__device__ __forceinline__ void transpose_item(const float* W, int K, int N, bf16* WT, const float* g, LAS float* scr, int item, int lane, int permup) {
    const int nblk = N / 32, kb = item / nblk, nb = item % nblk, k0 = 64 * kb, n0 = 32 * nb;
    float wv[32];
#pragma unroll
    for (int i = 0; i < 32; ++i) wv[i] = W[(size_t)(k0 + 2 * i + (lane >> 5)) * N + n0 + (lane & 31)];
#pragma unroll
    for (int i = 0; i < 32; ++i) { const int kk = 2 * i + (lane >> 5); float w = wv[i]; if (g) w *= g[k0 + kk]; scr[kk * 33 + (lane & 31)] = w; }
    asm volatile("s_waitcnt lgkmcnt(0)" ::: "memory");
    const int c = lane & 7;
#pragma unroll
    for (int j = 0; j < 4; ++j) { const int n = (lane >> 3) + 8 * j; const LAS float* s = scr + (8 * c) * 33 + n;
        u32x4 o; o.x = pk2(s[0 * 33], s[1 * 33]); o.y = pk2(s[2 * 33], s[3 * 33]); o.z = pk2(s[4 * 33], s[5 * 33]); o.w = pk2(s[6 * 33], s[7 * 33]);
        const int nrow = permup == 1 ? perm_up(n0 + n) : permup == 2 ? perm_in(n0 + n) : n0 + n;
        *(u32x4*)(WT + (size_t)nrow * K + k0 + 8 * c) = o; }
    asm volatile("s_waitcnt lgkmcnt(0)" ::: "memory");
}
struct ConvJob { const float* W; const float* g; bf16* WT; int K, N; int permup; };
__device__ __forceinline__ void convert_weights(const ConvJob& j0, const ConvJob& j1, const ConvJob& j2, const ConvJob& j3, int njobs, LAS float* scr, int gw, int NGW, int lane) {
    const int n0 = (j0.K / 64) * (j0.N / 32), n1 = njobs > 1 ? (j1.K / 64) * (j1.N / 32) : 0, n2 = njobs > 2 ? (j2.K / 64) * (j2.N / 32) : 0, n3 = njobs > 3 ? (j3.K / 64) * (j3.N / 32) : 0;
    const int total = n0 + n1 + n2 + n3;
    for (int it = gw; it < total; it += NGW) {
        if (it < n0) transpose_item(j0.W, j0.K, j0.N, j0.WT, j0.g, scr, it, lane, j0.permup);
        else if (it < n0 + n1) transpose_item(j1.W, j1.K, j1.N, j1.WT, j1.g, scr, it - n0, lane, j1.permup);
        else if (it < n0 + n1 + n2) transpose_item(j2.W, j2.K, j2.N, j2.WT, j2.g, scr, it - n0 - n1, lane, j2.permup);
        else transpose_item(j3.W, j3.K, j3.N, j3.WT, j3.g, scr, it - n0 - n1 - n2, lane, j3.permup);
    }
}
__device__ __forceinline__ u32x4 norm_rope8(u32x4 raw, const float* g, int s8, int t, float scale) {
    float x[8] = {bf_lo(raw.x), bf_hi(raw.x), bf_lo(raw.y), bf_hi(raw.y), bf_lo(raw.z), bf_hi(raw.z), bf_lo(raw.w), bf_hi(raw.w)};
    float ss = 0.f;
#pragma unroll
    for (int e = 0; e < 8; ++e) ss += x[e] * x[e];
    ss += __shfl_xor(ss, 1); ss += __shfl_xor(ss, 2); ss += __shfl_xor(ss, 4);
    const float rs = __builtin_amdgcn_rsqf(ss * (1.0f / 64.0f) + EPS);
    const f32x4 g0 = *(const f32x4*)(g + s8 * 8), g1 = *(const f32x4*)(g + s8 * 8 + 4);
    const float gg[8] = {g0[0], g0[1], g0[2], g0[3], g1[0], g1[1], g1[2], g1[3]};
    const float pos = (float)((s8 < 4) ? (t >> 6) : (t & 63));
    const float sgn = (s8 & 2) ? 1.0f : -1.0f;
    const int j0 = (s8 & 1) * 8;
    float o[8];
#pragma unroll
    for (int e = 0; e < 8; ++e) {
        const float xn = x[e] * rs * gg[e];
        const float other = __shfl_xor(xn, 2);
        const float inv = __builtin_amdgcn_exp2f(-(float)(j0 + e) * (13.287712379549449f / 16.0f));
        const float ang = pos * inv;
        const float c = __cosf(ang), sn = __sinf(ang);
        o[e] = (xn * c + sgn * other * sn) * scale;
    }
    u32x4 w; w.x = pk2(o[0], o[1]); w.y = pk2(o[2], o[3]); w.z = pk2(o[4], o[5]); w.w = pk2(o[6], o[7]); return w;
}
struct RowRaw { u32x4 cb, cc0, cc1, cc2, cx0, cx1, cx2; };
__device__ __forceinline__ RowRaw p1b_load(const bf16* praw, int m, int lane) {
    RowRaw R; const int t = m & (SEQ - 1), c = (lane & 31) * 8; const u32x4 z = (u32x4){0u, 0u, 0u, 0u};
    const bf16* pr = praw + (size_t)m * PROJ_W;
    R.cb = *(const u32x4*)(pr + OFF_CB + c); R.cc1 = *(const u32x4*)(pr + OFF_CC + c); R.cx1 = *(const u32x4*)(pr + OFF_CX + c);
    R.cc0 = t > 0 ? *(const u32x4*)(pr - PROJ_W + OFF_CC + c) : z; R.cx0 = t > 0 ? *(const u32x4*)(pr - PROJ_W + OFF_CX + c) : z;
    R.cc2 = t < SEQ - 1 ? *(const u32x4*)(pr + PROJ_W + OFF_CC + c) : z; R.cx2 = t < SEQ - 1 ? *(const u32x4*)(pr + PROJ_W + OFF_CX + c) : z;
    return R;
}
__device__ __forceinline__ void p1b_proc(const RowRaw& R, int m, bool valid, bf16* mix, const f32x4 (&wt)[3][2], int lane) {
    const int c = (lane & 31) * 8;
    float o[8];
#pragma unroll
    for (int h = 0; h < 4; ++h) {
        const float p0l = bf_lo(R.cc0[h]) * bf_lo(R.cx0[h]), p0h = bf_hi(R.cc0[h]) * bf_hi(R.cx0[h]);
        const float p1l = bf_lo(R.cc1[h]) * bf_lo(R.cx1[h]), p1h = bf_hi(R.cc1[h]) * bf_hi(R.cx1[h]);
        const float p2l = bf_lo(R.cc2[h]) * bf_lo(R.cx2[h]), p2h = bf_hi(R.cc2[h]) * bf_hi(R.cx2[h]);
        const int e0 = 2 * h, e1 = 2 * h + 1;
        o[e0] = bf_lo(R.cb[h]) * (wt[0][e0 >> 2][e0 & 3] * p0l + wt[1][e0 >> 2][e0 & 3] * p1l + wt[2][e0 >> 2][e0 & 3] * p2l);
        o[e1] = bf_hi(R.cb[h]) * (wt[0][e1 >> 2][e1 & 3] * p0h + wt[1][e1 >> 2][e1 & 3] * p1h + wt[2][e1 >> 2][e1 & 3] * p2h);
    }
    u32x4 w; w.x = pk2(o[0], o[1]); w.y = pk2(o[2], o[3]); w.z = pk2(o[4], o[5]); w.w = pk2(o[6], o[7]);
    if (valid) *(u32x4*)(mix + (size_t)m * 1024 + 768 + c) = w;
}
__device__ __forceinline__ void p1b_rows(const bf16* praw, bf16* mix, const float* convw, int gw, int NGW, int lane) {
    const int half = lane >> 5, c = (lane & 31) * 8;
    f32x4 wt[3][2];
#pragma unroll
    for (int k = 0; k < 3; ++k) { wt[k][0] = *(const f32x4*)(convw + k * 256 + c); wt[k][1] = *(const f32x4*)(convw + k * 256 + c + 4); }
    for (int k0 = 0; gw + k0 * NGW < MTOK; k0 += 8) {
        RowRaw R[4]; int mm[4]; bool ok[4];
#pragma unroll
        for (int i = 0; i < 4; ++i) { mm[i] = gw + (k0 + 2 * i + half) * NGW; ok[i] = mm[i] < MTOK; R[i] = p1b_load(praw, ok[i] ? mm[i] : gw, lane); }
#pragma unroll
        for (int i = 0; i < 4; ++i) p1b_proc(R[i], mm[i], ok[i], mix, wt, lane);
    }
}
__device__ __forceinline__ void sg_item(LAS unsigned char* lds, int item, const bf16* praw, const bf16* sgw, const float* sgb, const float* gsg, bf16* mix, int wave, int lane) {
    const int n = item >> 1, ph = item & 1;
    const size_t m0 = (size_t)n * 128;
    LAS float* psum = (LAS float*)lds;
    LAS bf16* vnT = (LAS bf16*)(lds + 4096);
    constexpr int VP = 136;
    const int fr = lane & 15, fq = lane >> 4, h = wave >> 1, cs = (wave & 1) * 32;
    bf16x8 afr[4][4]; u32x2 suv[4][2]; float biasv[4];
#pragma unroll
    for (int mb = 0; mb < 4; ++mb) {
#pragma unroll
        for (int kk = 0; kk < 4; ++kk) afr[mb][kk] = *(const bf16x8*)(sgw + ((size_t)(h * 128 + ph * 64 + mb * 16 + fr) * 128 + kk * 32 + fq * 8));
        const int p = ph * 64 + mb * 16 + fr; biasv[mb] = sgb[h * 128 + p];
#pragma unroll
        for (int nb = 0; nb < 2; ++nb) suv[mb][nb] = *(const u32x2*)(praw + (m0 + p) * PROJ_W + OFF_SU + h * 64 + cs + nb * 16 + 4 * fq);
    }
    u32x4 raw[2][4];
#pragma unroll
    for (int hh = 0; hh < 2; ++hh) {
        const int q = hh * 64 + lane;
        const bf16* src = praw + (m0 + q) * PROJ_W + OFF_SV + wave * 32;
        float ss = 0.f;
#pragma unroll
        for (int i = 0; i < 4; ++i) { raw[hh][i] = *(const u32x4*)(src + i * 8);
#pragma unroll
            for (int h = 0; h < 4; ++h) { const float a = bf_lo(raw[hh][i][h]), b = bf_hi(raw[hh][i][h]); ss += a * a + b * b; } }
        psum[wave * 128 + q] = ss;
    }
    __syncthreads();
#pragma unroll
    for (int hh = 0; hh < 2; ++hh) {
        const int q = hh * 64 + lane;
        float tot = 0.f;
#pragma unroll
        for (int w = 0; w < 8; ++w) tot += psum[w * 128 + q];
        const float rs = __builtin_amdgcn_rsqf(tot * (1.0f / 256.0f) + EPS);
#pragma unroll
        for (int i = 0; i < 4; ++i)
#pragma unroll
            for (int h = 0; h < 4; ++h) {
                const int c = wave * 32 + i * 8 + 2 * h;
                const unsigned w2 = pk2(bf_lo(raw[hh][i][h]) * rs * gsg[c], bf_hi(raw[hh][i][h]) * rs * gsg[c + 1]);
                vnT[c * VP + q] = (bf16)(w2 & 0xffffu); vnT[(c + 1) * VP + q] = (bf16)(w2 >> 16);
            }
    }
    __syncthreads();
    f32x4 acc[4][2];
#pragma unroll
    for (int mb = 0; mb < 4; ++mb)
#pragma unroll
        for (int nb = 0; nb < 2; ++nb) acc[mb][nb] = (f32x4){0.f, 0.f, 0.f, 0.f};
#pragma unroll
    for (int kk = 0; kk < 4; ++kk) {
        bf16x8 bfr[2];
#pragma unroll
        for (int nb = 0; nb < 2; ++nb) bfr[nb] = *(const LAS bf16x8*)(vnT + (h * 64 + cs + nb * 16 + fr) * VP + kk * 32 + fq * 8);
#pragma unroll
        for (int mb = 0; mb < 4; ++mb) {
#pragma unroll
            for (int nb = 0; nb < 2; ++nb) acc[mb][nb] = __builtin_amdgcn_mfma_f32_16x16x32_bf16(bfr[nb], afr[mb][kk], acc[mb][nb], 0, 0, 0);
        }
    }
#pragma unroll
    for (int mb = 0; mb < 4; ++mb) {
        const int p = ph * 64 + mb * 16 + fr;
        const float bias = biasv[mb];
        const size_t m = m0 + p;
#pragma unroll
        for (int nb = 0; nb < 2; ++nb) {
            const int c = h * 64 + cs + nb * 16 + 4 * fq;
            const u32x2 su = suv[mb][nb];
            const f32x4 a = acc[mb][nb];
            u32x2 w; w.x = pk2(bf_lo(su.x) * (a[0] + bias), bf_hi(su.x) * (a[1] + bias)); w.y = pk2(bf_lo(su.y) * (a[2] + bias), bf_hi(su.y) * (a[3] + bias));
            *(u32x2*)(mix + m * 1024 + 512 + c) = w;
        }
    }
    __syncthreads();
}
__device__ __forceinline__ void act_fixup(int pm, const float* halo, const float* cw, bf16* act, int tid) {
    for (int idx = tid; idx < 2 * (D_FF / 4); idx += NWAVES * 64) {
        const int which = idx / (D_FF / 4), c = (idx - which * (D_FF / 4)) * 4;
        const int hoff = (c >> 7) * 256 + (c & 127);
        const int row = pm * 256 + (which ? 255 : 0), t = row & (SEQ - 1);
        const f32x4 z = (f32x4){0.f, 0.f, 0.f, 0.f};
        const float* hc = halo + (size_t)(pm * 4 + (which ? 3 : 0)) * D_FF2 + hoff;
        const float* hp = which ? halo + (size_t)(pm * 4 + 2) * D_FF2 + hoff : halo + (size_t)((pm - 1) * 4 + 3) * D_FF2 + hoff;
        const float* hn = which ? halo + (size_t)((pm + 1) * 4 + 0) * D_FF2 + hoff : halo + (size_t)(pm * 4 + 1) * D_FF2 + hoff;
        const bool hasp = t > 0, hasn = t < SEQ - 1;
        const f32x4 gc = *(const f32x4*)hc, vc = *(const f32x4*)(hc + 128);
        const f32x4 gp = hasp ? *(const f32x4*)hp : z, vp = hasp ? *(const f32x4*)(hp + 128) : z;
        const f32x4 gn = hasn ? *(const f32x4*)hn : z, vn = hasn ? *(const f32x4*)(hn + 128) : z;
        const f32x4 wg0 = *(const f32x4*)(cw + c), wg1 = *(const f32x4*)(cw + D_FF2 + c), wg2 = *(const f32x4*)(cw + 2 * D_FF2 + c);
        const f32x4 wv0 = *(const f32x4*)(cw + D_FF + c), wv1 = *(const f32x4*)(cw + D_FF2 + D_FF + c), wv2 = *(const f32x4*)(cw + 2 * D_FF2 + D_FF + c);
        const f32x4 g = wg0 * gp + wg1 * gc + wg2 * gn, v = wv0 * vp + wv1 * vc + wv2 * vn;
        float o[4];
#pragma unroll
        for (int j2 = 0; j2 < 4; ++j2) o[j2] = g[j2] * __builtin_amdgcn_rcpf(1.0f + __builtin_amdgcn_exp2f(-1.4426950408889634f * g[j2])) * v[j2];
        u32x2 w; w.x = pk2(o[0], o[1]); w.y = pk2(o[2], o[3]);
        *(u32x2*)(act + (size_t)row * D_FF + c) = w;
    }
}

#define GAS __attribute__((address_space(1)))
#define RLX_AGENT __ATOMIC_RELAXED, __HIP_MEMORY_SCOPE_AGENT
#define XB_TMO      128
#define XB_XCNT(j)  (256  + 64 * (j))
#define XB_XSUB(j)  (1280 + 64 * (j))
#define XB_XGEN(j)  (2304 + 64 * (j))
#define XB_TOP      3328
#define XB_TOPGEN   3392
#define XCD_BAR_WORDS 3456
#define XB_SPIN_CAP (1u << 18)

__device__ __forceinline__ unsigned xb_ld(unsigned* p)              { return __hip_atomic_load(p, __ATOMIC_RELAXED, __HIP_MEMORY_SCOPE_AGENT); }
__device__ __forceinline__ unsigned xb_add(unsigned* p, unsigned v) { return __hip_atomic_fetch_add(p, v, __ATOMIC_RELAXED, __HIP_MEMORY_SCOPE_AGENT); }
__device__ __forceinline__ unsigned xb_xcc_id() { return (unsigned)__builtin_amdgcn_s_getreg((3 << 11) | 20) & 0xFu; }
#define XB_SPIN(cond, bar) do { unsigned _sp = 0; while (cond) { __builtin_amdgcn_s_sleep(1); \
    if ((++_sp & 255u) == 0u) { if (xb_ld(&(bar)[XB_TMO])) break; if (_sp > XB_SPIN_CAP) { atomicAdd(&(bar)[XB_TMO], 1u); break; } } } } while (0)

struct XcdBarrier {
    unsigned* bar; unsigned x;
    volatile LAS unsigned* st;
};

__device__ __forceinline__ XcdBarrier xcd_barrier_post(unsigned* bar, volatile LAS unsigned* st) {
    XcdBarrier b; b.bar = bar; b.x = xb_xcc_id(); b.st = st;
    if (threadIdx.x == 0) (void)xb_add(&bar[XB_XCNT(b.x)], 1u);
    return b;
}
__device__ __forceinline__ void xcd_barrier_complete(unsigned* bar, unsigned x, unsigned& nloc, unsigned& nx) {
    const unsigned G = gridDim.x * gridDim.y * gridDim.z;
    unsigned sum, cnt, mine, sp = 0u;
    for (;;) {
        sum = 0u; cnt = 0u; mine = 0u;
#pragma unroll
        for (unsigned j = 0; j < 16; ++j) { const unsigned c = xb_ld(&bar[XB_XCNT(j)]); sum += c; cnt += (c > 0u) ? 1u : 0u; mine = (j == x) ? c : mine; }
        if (sum == G) break;
        __builtin_amdgcn_s_sleep(1);
        if ((++sp & 255u) == 0u) { if (xb_ld(&bar[XB_TMO])) break; if (sp > XB_SPIN_CAP) { atomicAdd(&bar[XB_TMO], 1u); break; } }
    }
    nloc = mine > 0u ? mine : 1u; nx = cnt > 0u ? cnt : 1u;
}

__device__ __forceinline__ void xcd_barrier(const XcdBarrier& b) {
    asm volatile("s_waitcnt vmcnt(0)" ::: "memory");
    __syncthreads();
    if (threadIdx.x == 0) {
        unsigned* bar = b.bar;
        __builtin_amdgcn_s_waitcnt(0);
        unsigned nloc = b.st[0], nx = b.st[1];
        if (nloc == 0u) { xcd_barrier_complete(bar, b.x, nloc, nx); b.st[0] = nloc; b.st[1] = nx; }
        const unsigned old = xb_add(&bar[XB_XSUB(b.x)], 1u);
        const unsigned gen = old / nloc;
        if (old + 1u == (gen + 1u) * nloc) {
            __builtin_amdgcn_fence(__ATOMIC_RELEASE, "agent");
            asm volatile("s_waitcnt vmcnt(0)" ::: "memory");
            const unsigned og = xb_add(&bar[XB_TOP], 1u);
            const unsigned tg = og / nx;
            if (og + 1u == (tg + 1u) * nx) xb_add(&bar[XB_TOPGEN], 1u);
            else XB_SPIN(xb_ld(&bar[XB_TOPGEN]) == tg, bar);
            __builtin_amdgcn_fence(__ATOMIC_ACQUIRE, "agent");
            xb_add(&bar[XB_XGEN(b.x)], 1u);
            asm volatile("s_waitcnt vmcnt(0)" ::: "memory");
        } else {
            XB_SPIN(xb_ld(&bar[XB_XGEN(b.x)]) == gen, bar);
            __builtin_amdgcn_fence(__ATOMIC_ACQUIRE, "agent");
            asm volatile("s_waitcnt vmcnt(0)" ::: "memory");
        }
    }
    __syncthreads();
}
constexpr int CW_BAR = 4096;
constexpr size_t CTL_ZERO_BYTES = 65536;
constexpr int MISC_OFF = 131072 + 320;

__device__ __forceinline__ void build_rstd_table(const float* part, const pg8::StaticOrder& S, int tid) {
    LAS float* tbl = (LAS float*)pg8::RSTD_TBL_OFF; pg8::Unit u;
    for (int i = 0; i < 8 && S.next(i, u); ++i)
        if (tid < 256) { const f32x4* pp = (const f32x4*)(part + (size_t)(u.pm * 256 + tid) * 16);
            const f32x4 p0 = pp[0], p1 = pp[1], p2 = pp[2], p3 = pp[3]; const f32x4 ps = (p0 + p1) + (p2 + p3);
            tbl[i * 256 + tid] = __builtin_amdgcn_rsqf(((ps[0] + ps[1]) + (ps[2] + ps[3])) * (1.0f / 1024.0f) + EPS); }
    __syncthreads();
}

struct Args { const float* in[14]; float* out; unsigned char* ws; };
enum { I_X = 0, I_N1G, I_WIN, I_QG, I_KG, I_SGG, I_SGW, I_SGB, I_CONVW, I_WOUT, I_N2G, I_WUP, I_FCW, I_WDOWN };

__global__ void __launch_bounds__(NWAVES * 64, 2) mk_fwd(Args args) {
    extern __shared__ __attribute__((aligned(16))) unsigned char lds_raw[];
    LAS unsigned char* lds = (LAS unsigned char*)lds_raw;
    cg::grid_group grid = cg::this_grid();
    for (int u = threadIdx.x; u < (LDS_BYTES - 131072) / 4; u += NWAVES * 64) ((LAS unsigned*)(lds + 131072))[u] = 0u;
    __syncthreads();
    (void)xcd_barrier_post((unsigned*)args.ws + CW_BAR, (volatile LAS unsigned*)(lds + MISC_OFF) + 8);
    grid.sync();
#ifndef REP_SYNC
#define REP_SYNC 1
#endif
#ifndef REP_P1
#define REP_P1 1
#endif
#ifndef REP_P1B
#define REP_P1B 1
#endif
#ifndef REP_ATT
#define REP_ATT 1
#endif
#ifndef REP_P4
#define REP_P4 1
#endif
#define GSYNC() do { for (int r_ = 0; r_ < REP_SYNC; ++r_) { XcdBarrier bar_; bar_.bar = (unsigned*)args.ws + CW_BAR; bar_.x = xb_xcc_id(); bar_.st = (volatile LAS unsigned*)(lds + MISC_OFF) + 8; xcd_barrier(bar_); } } while (0)
#ifndef PHMASK
#define PHMASK 0xff
#endif
#define PH(k) ((PHMASK >> (k)) & 1)
#define PHASE_VARS() PHASE_VARS_L(l)
#define PHASE_VARS_L(LAYER) int tid = threadIdx.x; asm volatile("" : "+v"(tid)); const int lane = tid & 63, wave = __builtin_amdgcn_readfirstlane(tid >> 6); \
    const int G = gridDim.x, bx = blockIdx.x; const int vcu = (G % 8 == 0) ? (bx % 8) * (G / 8) + bx / 8 : bx; const int NGW = G * NWAVES; const int gw = vcu * NWAVES + wave; (void)NGW; \
    GAS unsigned char* wsg_ = (GAS unsigned char*)args.ws; asm volatile("" : "+s"(wsg_)); unsigned char* ws = (unsigned char*)wsg_;     (void)lane; (void)gw; \
    float* part1 = (float*)(ws + WS_PART1); float* part2 = (float*)(ws + WS_PART2); bf16* sgw_b = (bf16*)(ws + WS_SGW); \
    unsigned char* wset = ws + WS_WSET + (size_t)(LAYER & 1) * WSET_BYTES; unsigned char* wnext = ws + WS_WSET + (size_t)((LAYER + 1) & 1) * WSET_BYTES; (void)wnext; \
    bf16* Win_t = (bf16*)(wset + WO_WIN); bf16* Wout_t = (bf16*)(wset + WO_WOUT); bf16* Wup_t = (bf16*)(wset + WO_WUP); bf16* Wdown_t = (bf16*)(wset + WO_WDOWN); \
    bf16* xb = (bf16*)(ws + WS_XB); float* halo = (float*)(ws + WS_HALO); bf16* praw = (bf16*)(ws + WS_PRAW); \
    bf16* qb = (bf16*)(ws + WS_Q); bf16* kb = (bf16*)(ws + WS_K); bf16* vb = (bf16*)(ws + WS_V); bf16* mix = (bf16*)(ws + WS_MIX); bf16* act = (bf16*)(ws + WS_ACT); \
    const float* x_in = args.in[I_X]; float* xres = args.out; LAS float* scr = (LAS float*)(lds + wave * 16384); \
    (void)part1; (void)part2; (void)sgw_b; (void)Win_t; (void)Wout_t; (void)Wup_t; (void)Wdown_t; (void)xb; (void)halo; (void)praw; (void)qb; (void)kb; (void)vb; (void)mix; (void)act; (void)x_in; (void)xres; (void)scr

    if (PH(0)) {
    PHASE_VARS_L(0);
    for (int m = gw; m < MTOK; m += NGW) {
        const f32x4* xr = (const f32x4*)(x_in + (size_t)m * DMODEL) + lane;
        unsigned long long* o8 = (unsigned long long*)(xb + (size_t)m * DMODEL) + lane;
        float ss = 0.f;
#pragma unroll
        for (int j = 0; j < 4; ++j) { const f32x4 v = xr[64 * j]; ss += (v[0] * v[0] + v[1] * v[1]) + (v[2] * v[2] + v[3] * v[3]);
            o8[64 * j] = (unsigned long long)pk2(v[0], v[1]) | ((unsigned long long)pk2(v[2], v[3]) << 32); }
        ss = wave_sum(ss);
        if (lane < 16) part1[(size_t)m * 16 + lane] = lane == 0 ? ss : 0.f;
    }
    { const float* sgw = args.in[I_SGW]; const int n8 = DEPTH * 4 * 128 * 128 / 8;
      for (int i = bx * 512 + tid; i < n8; i += G * 512) { const f32x4 a = *(const f32x4*)(sgw + (size_t)i * 8), b = *(const f32x4*)(sgw + (size_t)i * 8 + 4);
          u32x4 w; w.x = pk2(a[0], a[1]); w.y = pk2(a[2], a[3]); w.z = pk2(b[0], b[1]); w.w = pk2(b[2], b[3]); *(u32x4*)(sgw_b + (size_t)i * 8) = w; } }
    { const ConvJob j0{args.in[I_WIN], args.in[I_N1G], Win_t, DMODEL, PROJ_W, 2}, j1{args.in[I_WOUT], nullptr, Wout_t, DMODEL, DMODEL, 0},
                    j2{args.in[I_WUP], args.in[I_N2G], Wup_t, DMODEL, D_FF2, 1}, j3{args.in[I_WDOWN], nullptr, Wdown_t, D_FF, DMODEL, 0};
      convert_weights(j0, j1, j2, j3, 4, scr, gw, NGW, lane); }
    }
    GSYNC();

#pragma unroll 1
    for (int l = 0; l < DEPTH; ++l) {
        for (int rp = 0; rp < REP_P1; ++rp) if (PH(1)) { PHASE_VARS();
          pg8::Gemm g{xb, Win_t, MTOK, PROJ_W, DMODEL}; pg8::StaticOrder S; S.init(MTOK, PROJ_W, G, bx);
          pg8::EpiInProj E{praw, PROJ_W, kb, vb, args.in[I_KG] + l * 64}; S.tbl_part = part1;
          pg8::gemm_phase<pg8::EpiInProj, pg8::StaticOrder, false, true>(lds, g, S, E, tid); }
        GSYNC();
        for (int rp = 0; rp < REP_ATT; ++rp) if (PH(3)) { PHASE_VARS();
          const attn_body::AttnTensors AT{(const attn_body::bf16*)praw, (const attn_body::bf16*)kb, (const attn_body::bf16*)vb, (attn_body::bf16*)mix, args.in[I_QG] + l * 64};
          const attn_body::StaticOrder S(G, vcu);
          float gqm = fabsf(args.in[I_QG][l * 64 + lane]), gkm = fabsf(args.in[I_KG][l * 64 + lane]);
#pragma unroll
          for (int o = 1; o < 64; o <<= 1) { gqm = fmaxf(gqm, __shfl_xor(gqm, o)); gkm = fmaxf(gkm, __shfl_xor(gkm, o)); }
          const bool fixed_ref = __builtin_amdgcn_readfirstlane((gqm * gkm < 4.0f) ? 1 : 0) != 0;
          if (fixed_ref) attn_body::attn_phase<attn_body::StaticOrder, 8, false>((char*)lds_raw, AT, S, tid);
          else attn_body::attn_phase<attn_body::StaticOrder, 8, true>((char*)lds_raw, AT, S, tid);
          for (int it = vcu; it < 256; it += G)
              sg_item(lds, it, praw, sgw_b + (size_t)l * 4 * 128 * 128, args.in[I_SGB] + l * 4 * 128, args.in[I_SGG] + l * 256, mix, wave, lane);
          p1b_rows(praw, mix, args.in[I_CONVW] + l * 3 * 256, gw, NGW, lane); }
        GSYNC();
        if (PH(4)) { PHASE_VARS();
          pg8::Gemm g{mix, Wout_t, MTOK, DMODEL, DMODEL}; pg8::StaticOrder S; S.init(MTOK, DMODEL, G, bx);
          pg8::EpiResid E{xb, part2, nullptr};
          pg8::gemm_phase<pg8::EpiResid, pg8::StaticOrder, true, true>(lds, g, S, E, tid); }
        GSYNC();
        for (int rp = 0; rp < REP_P4; ++rp) if (PH(5)) { PHASE_VARS();
          pg8::Gemm g{xb, Wup_t, MTOK, D_FF2, DMODEL}; pg8::StaticOrder S; S.init(MTOK, D_FF2, G, bx);
          pg8::EpiConvAct E{act, args.in[I_FCW] + (size_t)l * 3 * D_FF2, (long)WS_HALO - (long)WS_ACT}; S.tbl_part = part2;
          pg8::gemm_phase<pg8::EpiConvAct, pg8::StaticOrder, true, true>(lds, g, S, E, tid); }
          if (PH(5) && l + 1 < DEPTH) { PHASE_VARS();
              const int nu = (MTOK / 256) * (D_FF2 / 256), rem = nu % G, first = rem ? rem : 0, nidle = G - first;
              if (bx >= first) { const int ln = l + 1; const int gw2 = (bx - first) * NWAVES + wave, NGW2 = nidle * NWAVES;
                  const ConvJob j0{args.in[I_WIN] + (size_t)ln * DMODEL * PROJ_W, args.in[I_N1G] + ln * DMODEL, (bf16*)(wnext + WO_WIN), DMODEL, PROJ_W, 2},
                                j1{args.in[I_WOUT] + (size_t)ln * DMODEL * DMODEL, nullptr, (bf16*)(wnext + WO_WOUT), DMODEL, DMODEL, 0},
                                j2{args.in[I_WUP] + (size_t)ln * DMODEL * D_FF2, args.in[I_N2G] + ln * DMODEL, (bf16*)(wnext + WO_WUP), DMODEL, D_FF2, 1},
                                j3{args.in[I_WDOWN] + (size_t)ln * D_FF * DMODEL, nullptr, (bf16*)(wnext + WO_WDOWN), D_FF, DMODEL, 0};
                  convert_weights(j0, j1, j2, j3, 4, scr, gw2, NGW2, lane); } }
        GSYNC();
        if (PH(7)) { PHASE_VARS();
          pg8::Gemm g{act, Wdown_t, MTOK, DMODEL, D_FF}; pg8::StaticOrder S; S.init(MTOK, DMODEL, G, bx);
          { pg8::Unit u; for (int i = 0; S.next(i, u); ++i) act_fixup(u.pm, halo, args.in[I_FCW] + (size_t)l * 3 * D_FF2, act, tid); }
          asm volatile("s_waitcnt vmcnt(0)" ::: "memory"); __syncthreads();
          pg8::EpiResid E{xb, part1, l + 1 == DEPTH ? xres : nullptr};
          pg8::gemm_phase<pg8::EpiResid, pg8::StaticOrder, true, true>(lds, g, S, E, tid); }
        if (l + 1 < DEPTH) GSYNC();
    }
}

extern "C" void kernel_launch(void* const* d_in, const int* in_sizes, int n_in, void* d_out, int out_size, void* d_ws, size_t ws_size, hipStream_t stream) {
    static int grid = 0;
    if (grid == 0) {
        if (n_in != 14 || out_size != MTOK * DMODEL || ws_size < WS_END) { fprintf(stderr, "kernel_launch: unexpected shapes / workspace (n_in %d out %d ws %zu, need %zu)\n", n_in, out_size, ws_size, (size_t)WS_END); grid = -1; return; }
        int dev = 0, cus = 0, per_cu = 0;
        hipGetDevice(&dev);
        hipDeviceGetAttribute(&cus, hipDeviceAttributeMultiprocessorCount, dev);
        hipFuncSetAttribute((const void*)mk_fwd, hipFuncAttributeMaxDynamicSharedMemorySize, LDS_BYTES);
        hipOccupancyMaxActiveBlocksPerMultiprocessor(&per_cu, (const void*)mk_fwd, NWAVES * 64, LDS_BYTES);
        if (per_cu < 1) per_cu = 1;
        grid = cus * per_cu;
        if (grid < 176) { fprintf(stderr, "kernel_launch: grid %d too small for the per-phase tables (needs >= 176 workgroups)\n", grid); grid = -1; return; }
        (void)hipGetLastError();
    }
    if (grid < 0) return;
    Args a{};
    for (int i = 0; i < 14; ++i) a.in[i] = (const float*)d_in[i];
    a.out = (float*)d_out; a.ws = (unsigned char*)d_ws;
    if (hipMemsetAsync(d_ws, 0, CTL_ZERO_BYTES, stream) != hipSuccess) { fprintf(stderr, "memset failed\n"); return; }
    void* kargs[] = {&a};
    hipError_t e = hipLaunchCooperativeKernel((const void*)mk_fwd, dim3(grid), dim3(NWAVES * 64), kargs, LDS_BYTES, stream);
    if (e != hipSuccess) fprintf(stderr, "cooperative launch failed: %s (grid %d)\n", hipGetErrorString(e), grid);
}
```

```cpp
#include <hip/hip_runtime.h>
#include <hip/hip_cooperative_groups.h>
#include <hip/hip_bf16.h>
#include <cstdio>
#include <cstdint>
#include <cmath>
namespace cg = cooperative_groups;
namespace pg8 {
#define PG8_LAS __attribute__((address_space(3)))
typedef unsigned short bf16_t;
typedef short bf16x8 __attribute__((ext_vector_type(8)));
typedef float f32x4 __attribute__((ext_vector_type(4)));
typedef unsigned u32x4 __attribute__((ext_vector_type(4)));
typedef unsigned u32x2 __attribute__((ext_vector_type(2)));
constexpr int BM = 256, BK = 64, HALF = 128, HTB = HALF * BK * 2  , STAGE_BYTES = 8 * HTB, NXCD = 8, WGM = 8;

__host__ __device__ __forceinline__ int lds_byte(int r, int c) { const int st = (r >> 4) * 2 + (c >> 5), rr = r & 15, cc = c & 31, ob = rr * 64 + cc * 2; return st * 1024 + (ob ^ (((ob >> 9) & 1) << 5)); }
__host__ __device__ __forceinline__ void stage_rc(int b, int& R, int& C) { const int st = b / 1024, sb = b % 1024, swz = sb ^ (((sb >> 9) & 1) << 5); R = (st >> 1) * 16 + swz / 64; C = (st & 1) * 32 + (swz % 64) / 2; }
__host__ __device__ __forceinline__ int perm32(int rho) { const int n = rho >> 4, i = rho & 15; return 8 * (i >> 2) + 4 * n + (i & 3); }

struct Unit { int pm, pn, slot; };
struct Gemm { const bf16_t* A; const bf16_t* Bt; int M, N, K; };

struct StaticOrder {
    int nM, nN, nwg, G, c;
    __host__ __device__ __forceinline__ void init(int M, int N, int G_, int c_) { nM = M / BM; nN = N / BM; nwg = nM * nN; G = G_; c = c_; }
    __host__ __device__ __forceinline__ bool next(int i, Unit& u) const {
        const long L = (long)i * G + c; if (L >= nwg) return false;
        int wgid = (int)L; { const int q = nwg / NXCD, r = nwg % NXCD, xcd = wgid % NXCD, off = wgid / NXCD; wgid = (xcd < r ? xcd * (q + 1) : r * (q + 1) + (xcd - r) * q) + off; }
        const int nig = WGM * nN, gid = wgid / nig, fm = gid * WGM, gsz = (nM - fm) < WGM ? (nM - fm) : WGM;
        u.pm = fm + ((wgid % nig) % gsz); u.pn = (wgid % nig) / gsz; u.slot = i; return true;
    }
    __device__ __forceinline__ void a_ready(const Unit&) const {}
    __device__ __forceinline__ void done(const Unit&) const {}
};

__device__ __forceinline__ unsigned cvt_pk_bf16(float lo, float hi) { unsigned r; asm volatile("v_cvt_pk_bf16_f32 %0, %1, %2" : "=v"(r) : "v"(lo), "v"(hi)); return r; }
typedef float f32x2 __attribute__((ext_vector_type(2)));
constexpr float RMS_EPS = 1e-6f;
constexpr int RSTD_TBL_OFF = 131072 + 1024 + 8192;
struct EpiScaleBf16 {
    static constexpr bool PERM = true, AFTER_DRAIN = false, INIT_ACC = false;
    bf16_t* O; int ldc;
    __device__ __forceinline__ void operator()(f32x4 (&acc)[2][2][4][2], const Unit& u, int wr, int wc, int fr, int fq) const {
        const int row0 = u.pm * BM + wr * 64 + fr, col0 = u.pn * BM + wc * 32 + 8 * fq;
        const PG8_LAS float* rsT = (const PG8_LAS float*)RSTD_TBL_OFF + u.slot * 256 + wr * 64 + fr;
        typedef __attribute__((address_space(1))) u32x4 gu32x4;
#pragma unroll
        for (int ai = 0; ai < 2; ++ai)
#pragma unroll
            for (int m = 0; m < 4; ++m) {
                const int r = row0 + ai * HALF + m * 16;
                const float rs = rsT[ai * HALF + m * 16];
                bf16_t* rowp = O + (size_t)r * ldc + col0;
#pragma unroll
                for (int bj = 0; bj < 2; ++bj) { const f32x4 v0 = acc[ai][bj][m][0] * rs, v1 = acc[ai][bj][m][1] * rs;
                    u32x4 w; w.x = cvt_pk_bf16(v0[0], v0[1]); w.y = cvt_pk_bf16(v0[2], v0[3]); w.z = cvt_pk_bf16(v1[0], v1[1]); w.w = cvt_pk_bf16(v1[2], v1[3]);
                    *(gu32x4*)(rowp + bj * HALF) = w; }
            }
    }
};
__device__ __forceinline__ float lane_xor32(float v) { const unsigned b = __float_as_uint(v); auto rr = __builtin_amdgcn_permlane32_swap(b, b, false, false); return __uint_as_float(rr[0] ^ rr[1] ^ b); }
struct EpiInProj {
    static constexpr bool PERM = true, AFTER_DRAIN = false, INIT_ACC = false;
    bf16_t* O; int ldc; bf16_t* kimg; bf16_t* vimg; const float* gk;
    __device__ __forceinline__ void operator()(f32x4 (&acc)[2][2][4][2], const Unit& u, int wr, int wc, int fr, int fq) const {
        const int row0 = u.pm * BM + wr * 64 + fr;
        const PG8_LAS float* rsT = (const PG8_LAS float*)RSTD_TBL_OFF + u.slot * 256 + wr * 64 + fr;
        typedef __attribute__((address_space(1))) u32x4 gu32x4;
        if (u.pn != 2) {
            const int col0 = u.pn * BM + wc * 32 + 8 * fq;
#pragma unroll
            for (int ai = 0; ai < 2; ++ai)
#pragma unroll
                for (int m = 0; m < 4; ++m) {
                    const int r = row0 + ai * HALF + m * 16;
                    const float rs = rsT[ai * HALF + m * 16];
                    bf16_t* rowp = O + (size_t)r * ldc + col0;
#pragma unroll
                    for (int bj = 0; bj < 2; ++bj) { const f32x4 v0 = acc[ai][bj][m][0] * rs, v1 = acc[ai][bj][m][1] * rs;
                        u32x4 w; w.x = cvt_pk_bf16(v0[0], v0[1]); w.y = cvt_pk_bf16(v0[2], v0[3]); w.z = cvt_pk_bf16(v1[0], v1[1]); w.w = cvt_pk_bf16(v1[2], v1[3]);
                        *(gu32x4*)(rowp + bj * HALF) = w; }
                }
            return;
        }
        { int ln = threadIdx.x; asm volatile("" : "+v"(ln)); fr = ln & 15; fq = (ln >> 4) & 3; }
        const int row0k = u.pm * BM + wr * 64 + fr; const PG8_LAS float* rsTk = (const PG8_LAS float*)RSTD_TBL_OFF + u.slot * 256 + wr * 64 + fr;
        const bool isk = wc < 2; const int kvh = wc & 1;
        float inv[8], gg[2][8];
#pragma unroll
        for (int e = 0; e < 8; ++e) { inv[e] = __builtin_amdgcn_exp2f(-(float)(8 * (fq & 1) + e) * (13.287712379549449f / 16.0f)); gg[0][e] = gk[8 * fq + e]; gg[1][e] = gk[32 + 8 * fq + e]; }
        const float sgn = (fq & 2) ? 1.0f : -1.0f;
#pragma unroll
        for (int ai = 0; ai < 2; ++ai) {
            float crow[8], srow[8];
            if (isk) { const float prow = (float)(((row0k + ai * HALF) & 8191) >> 6);
#pragma unroll
                for (int e = 0; e < 8; ++e) { const float ang = prow * inv[e]; crow[e] = __cosf(ang); srow[e] = __sinf(ang); } }
#pragma unroll
            for (int m = 0; m < 4; ++m) {
                const int r = row0k + ai * HALF + m * 16, t = r & 8191, bb = r >> 13, tile = t >> 6, r6 = t & 63;
                const float rs = rsTk[ai * HALF + m * 16];
                float x[2][8]; float ss = 0.f;
#pragma unroll
                for (int bj = 0; bj < 2; ++bj)
#pragma unroll
                    for (int e = 0; e < 8; ++e) { x[bj][e] = acc[ai][bj][m][e >> 2][e & 3] * rs; ss += x[bj][e] * x[bj][e]; }
                const size_t img = ((size_t)(bb * 2 + kvh) * 128 + tile) * 4096;
                if (isk) {
                    ss += __shfl_xor(ss, 16); ss += lane_xor32(ss);
                    const float rk = __builtin_amdgcn_rsqf(ss * (1.0f / 64.0f) + RMS_EPS);
#pragma unroll
                    for (int bj = 0; bj < 2; ++bj) {
                        const float pos = (float)(bj == 0 ? (t >> 6) : (t & 63));
                        float o[8];
#pragma unroll
                        for (int e = 0; e < 8; ++e) {
                            const float xn = x[bj][e] * rk * gg[bj][e];
                            const float other = lane_xor32(xn);
                            float c, sn;
                            if (bj == 0) { c = crow[e]; sn = srow[e]; } else { const float ang = pos * inv[e]; c = __cosf(ang); sn = __sinf(ang); }
                            o[e] = xn * c + sgn * other * sn;
                        }
                        u32x4 w; w.x = cvt_pk_bf16(o[0], o[1]); w.y = cvt_pk_bf16(o[2], o[3]); w.z = cvt_pk_bf16(o[4], o[5]); w.w = cvt_pk_bf16(o[6], o[7]);
                        *(gu32x4*)(kimg + img + (4 * bj + fq) * 512 + r6 * 8) = w;
                    }
                } else {
#pragma unroll
                    for (int bj = 0; bj < 2; ++bj) {
                        u32x4 w; w.x = cvt_pk_bf16(x[bj][0], x[bj][1]); w.y = cvt_pk_bf16(x[bj][2], x[bj][3]); w.z = cvt_pk_bf16(x[bj][4], x[bj][5]); w.w = cvt_pk_bf16(x[bj][6], x[bj][7]);
                        *(gu32x4*)(vimg + img + (bj * 4 + (r6 >> 4)) * 512 + ((r6 & 15) * 4 + fq) * 8) = w;
                    }
                }
                asm volatile("" ::: "memory"); __builtin_amdgcn_sched_barrier(0);
            }
        }
    }
};
struct EpiResid {
    static constexpr bool PERM = true, AFTER_DRAIN = false, INIT_ACC = true;
    bf16_t* xb; float* part; float* out;
    __device__ __forceinline__ void init(f32x4 (&acc)[2][2][4][2], const Unit& u, int wr, int wc, int fr, int fq) const {
        const int row0 = u.pm * BM + wr * 64 + fr, col0 = u.pn * BM + wc * 32 + 8 * fq;
        typedef __attribute__((address_space(1))) u32x4 gu32x4;
#pragma unroll
        for (int ai = 0; ai < 2; ++ai)
#pragma unroll
            for (int m = 0; m < 4; ++m)
#pragma unroll
                for (int bj = 0; bj < 2; ++bj) {
                    const u32x4 raw = *(const gu32x4*)(xb + (size_t)(row0 + ai * HALF + m * 16) * 1024 + col0 + bj * HALF);
                    acc[ai][bj][m][0] = (f32x4){__uint_as_float(raw.x << 16), __uint_as_float(raw.x & 0xffff0000u), __uint_as_float(raw.y << 16), __uint_as_float(raw.y & 0xffff0000u)};
                    acc[ai][bj][m][1] = (f32x4){__uint_as_float(raw.z << 16), __uint_as_float(raw.z & 0xffff0000u), __uint_as_float(raw.w << 16), __uint_as_float(raw.w & 0xffff0000u)};
                }
    }
    __device__ __forceinline__ void operator()(f32x4 (&acc)[2][2][4][2], const Unit& u, int wr, int wc, int fr, int fq) const {
        const int row0 = u.pm * BM + wr * 64 + fr, col0 = u.pn * BM + wc * 32 + 8 * fq;
        typedef __attribute__((address_space(1))) u32x4 gu32x4; typedef __attribute__((address_space(1))) f32x4 gf32x4;
#pragma unroll
        for (int ai = 0; ai < 2; ++ai)
#pragma unroll
            for (int m = 0; m < 4; ++m) {
                const int r = row0 + ai * HALF + m * 16;
                const size_t off = (size_t)r * 1024 + col0;
                float ss = 0.f;
#pragma unroll
                for (int bj = 0; bj < 2; ++bj) {
                    const f32x4 v0 = acc[ai][bj][m][0], v1 = acc[ai][bj][m][1];
                    if (out) { *(gf32x4*)(out + off + bj * HALF) = v0; *(gf32x4*)(out + off + bj * HALF + 4) = v1; }
                    else {
                        u32x4 w; w.x = cvt_pk_bf16(v0[0], v0[1]); w.y = cvt_pk_bf16(v0[2], v0[3]); w.z = cvt_pk_bf16(v1[0], v1[1]); w.w = cvt_pk_bf16(v1[2], v1[3]);
                        *(gu32x4*)(xb + off + bj * HALF) = w;
                        ss += (v0[0] * v0[0] + v0[1] * v0[1]) + (v0[2] * v0[2] + v0[3] * v0[3]) + (v1[0] * v1[0] + v1[1] * v1[1]) + (v1[2] * v1[2] + v1[3] * v1[3]);
                    }
                }
                if (!out) { ss += __shfl_xor(ss, 16); ss += __shfl_xor(ss, 32);
                    if (fq == 0) part[(size_t)r * 16 + u.pn * 4 + wc] = ss; }
                if (m & 1) asm volatile("" ::: "memory");
            }
    }
};
__device__ __forceinline__ float dpp_ror1(float v) { return __builtin_bit_cast(float, __builtin_amdgcn_mov_dpp(__builtin_bit_cast(int, v), 0x121, 0xf, 0xf, true)); }
__device__ __forceinline__ float dpp_rol1(float v) { return __builtin_bit_cast(float, __builtin_amdgcn_mov_dpp(__builtin_bit_cast(int, v), 0x12f, 0xf, 0xf, true)); }
struct EpiConvAct {
    static constexpr bool PERM = true, AFTER_DRAIN = false, INIT_ACC = false;
    bf16_t* act; const float* cw; long halo_off;
    __device__ __forceinline__ void operator()(f32x4 (&acc)[2][2][4][2], const Unit& u, int wr, int wc, int fr, int fq) const {
        float* halo = (float*)((char*)act + halo_off); PG8_LAS float* ex = (PG8_LAS float*)(131072 + 1024);
        const int row0 = u.pm * BM + wr * 64 + fr, cl = wc * 32 + 8 * fq;
        typedef __attribute__((address_space(1))) const f32x4 gf32x4;
        const PG8_LAS float* rsT = (const PG8_LAS float*)RSTD_TBL_OFF + u.slot * 256;
#pragma unroll
        for (int ai = 0; ai < 2; ++ai)
#pragma unroll
            for (int m = 0; m < 4; ++m) {
                const float rs = rsT[wr * 64 + fr + ai * HALF + m * 16];
#pragma unroll
                for (int bj = 0; bj < 2; ++bj)
#pragma unroll
                    for (int n = 0; n < 2; ++n) acc[ai][bj][m][n] *= rs;
            }
#pragma unroll
        for (int ai = 0; ai < 2; ++ai) {
            const int gidx = ai * 2 + wr;
            if (fr == 0) {
#pragma unroll
                for (int bj = 0; bj < 2; ++bj)
#pragma unroll
                    for (int n = 0; n < 2; ++n) *(PG8_LAS f32x4*)(ex + (gidx * 2 + 0) * 256 + bj * HALF + cl + 4 * n) = acc[ai][bj][0][n];
            }
            if (fr == 15) {
#pragma unroll
                for (int bj = 0; bj < 2; ++bj)
#pragma unroll
                    for (int n = 0; n < 2; ++n) *(PG8_LAS f32x4*)(ex + (gidx * 2 + 1) * 256 + bj * HALF + cl + 4 * n) = acc[ai][bj][3][n];
            }
        }
        if (wr == 0 && fr < 2) {
#pragma unroll
            for (int bj = 0; bj < 2; ++bj)
#pragma unroll
                for (int n = 0; n < 2; ++n) *(__attribute__((address_space(1))) f32x4*)(halo + (size_t)(u.pm * 4 + fr) * 5632 + u.pn * BM + bj * HALF + cl + 4 * n) = acc[0][bj][0][n];
        }
        if (wr == 1 && fr >= 14) {
#pragma unroll
            for (int bj = 0; bj < 2; ++bj)
#pragma unroll
                for (int n = 0; n < 2; ++n) *(__attribute__((address_space(1))) f32x4*)(halo + (size_t)(u.pm * 4 + 2 + (fr - 14)) * 5632 + u.pn * BM + bj * HALF + cl + 4 * n) = acc[1][bj][3][n];
        }
        asm volatile("s_waitcnt lgkmcnt(0)" ::: "memory"); __builtin_amdgcn_s_barrier(); asm volatile("" ::: "memory");
        const int ccol = u.pn * HALF + cl;
        u32x2 res0[2][4];
#pragma unroll
        for (int n = 0; n < 2; ++n) {
            f32x4 wgt[3][2];
#pragma unroll
            for (int k = 0; k < 3; ++k) { wgt[k][0] = *(gf32x4*)(cw + k * 5632 + ccol + 4 * n); wgt[k][1] = *(gf32x4*)(cw + k * 5632 + 2816 + ccol + 4 * n); }
#pragma unroll
            for (int ai = 0; ai < 2; ++ai) {
                const int gidx = ai * 2 + wr;
                f32x4 top[2], bot[2];
#pragma unroll
                for (int bj = 0; bj < 2; ++bj) {
                    top[bj] = gidx > 0 ? *(const PG8_LAS f32x4*)(ex + ((gidx - 1) * 2 + 1) * 256 + bj * HALF + cl + 4 * n) : (f32x4){0.f, 0.f, 0.f, 0.f};
                    bot[bj] = gidx < 3 ? *(const PG8_LAS f32x4*)(ex + ((gidx + 1) * 2 + 0) * 256 + bj * HALF + cl + 4 * n) : (f32x4){0.f, 0.f, 0.f, 0.f};
                }
#pragma unroll
                for (int m = 0; m < 4; ++m) {
                    f32x2 y[2][2];
#pragma unroll
                    for (int bj = 0; bj < 2; ++bj) {
                        const f32x4 cur = acc[ai][bj][m][n];
#pragma unroll
                        for (int p = 0; p < 2; ++p) {
                            f32x2 prev2, next2, cur2 = (f32x2){cur[2 * p], cur[2 * p + 1]};
#pragma unroll
                            for (int q = 0; q < 2; ++q) { const int j = 2 * p + q;
                                const float pin = dpp_ror1(cur[j]);
                                const float pedge = (m > 0) ? dpp_ror1(acc[ai][bj][m > 0 ? m - 1 : 0][n][j]) : top[bj][j];
                                const float nin = dpp_rol1(cur[j]);
                                const float nedge = (m < 3) ? dpp_rol1(acc[ai][bj][m < 3 ? m + 1 : 3][n][j]) : bot[bj][j];
                                prev2[q] = fr == 0 ? pedge : pin; next2[q] = fr == 15 ? nedge : nin; }
                            const f32x2 w0 = (f32x2){wgt[0][bj][2 * p], wgt[0][bj][2 * p + 1]}, w1 = (f32x2){wgt[1][bj][2 * p], wgt[1][bj][2 * p + 1]}, w2 = (f32x2){wgt[2][bj][2 * p], wgt[2][bj][2 * p + 1]};
                            y[bj][p] = w0 * prev2 + w1 * cur2 + w2 * next2;
                        }
                    }
                    float o[4];
#pragma unroll
                    for (int p = 0; p < 2; ++p) {
                        const f32x2 g = y[0][p], t = g * -1.4426950408889634f;
                        f32x2 e; e[0] = __builtin_amdgcn_exp2f(t[0]); e[1] = __builtin_amdgcn_exp2f(t[1]);
                        const f32x2 d = e + 1.0f;
                        f32x2 r; r[0] = __builtin_amdgcn_rcpf(d[0]); r[1] = __builtin_amdgcn_rcpf(d[1]);
                        const f32x2 o2 = (g * r) * y[1][p];
                        o[2 * p] = o2[0]; o[2 * p + 1] = o2[1];
                    }
                    const int r = row0 + ai * HALF + m * 16;
                    u32x2 w; w.x = cvt_pk_bf16(o[0], o[1]); w.y = cvt_pk_bf16(o[2], o[3]);
                    if (n == 0) res0[ai][m] = w;
                    else { u32x4 w4; w4.x = res0[ai][m].x; w4.y = res0[ai][m].y; w4.z = w.x; w4.w = w.y; *(__attribute__((address_space(1))) u32x4*)(act + (size_t)r * 2816 + ccol) = w4; }
                    asm volatile("" ::: "memory"); __builtin_amdgcn_sched_barrier(0);
                }
            }
        }
    }
};

template <class Epi, class Sched, bool ALIGN_EPI = false, bool SP2 = false>
__device__ __forceinline__ void gemm_phase(PG8_LAS unsigned char* lds, const Gemm g, const Sched& S, const Epi& E, const int tid) {
    const int wid = __builtin_amdgcn_readfirstlane(tid >> 6), lane = tid & 63, wr = wid >> 2, wc = wid & 3, fr = lane & 15, fq = lane >> 4;
    const int K = g.K, nt = K / BK;
    unsigned voffA[2], voffB[2];
#pragma unroll
    for (int i = 0; i < 2; ++i) { int R, C; stage_rc(tid * 16 + i * 8192, R, C); const int Rb = Epi::PERM ? ((R & ~31) + perm32(R & 31)) : R;
        voffA[i] = (unsigned)(R * K + C) * 2u; voffB[i] = (unsigned)(Rb * K + C) * 2u; }
    const size_t kstep = (size_t)(BK * 2);
    const size_t hstep = (size_t)HALF * K * 2;
    const size_t tstep = 2 * hstep;
    const unsigned ldsw = (unsigned)wid * 1024u;
    const int aoff = lds_byte(wr * 64 + fr, fq * 8), boff = lds_byte(wc * 32 + fr, fq * 8);
#define PG8_SA(b, h) (((b) * 2 + (h)) * HTB)
#define PG8_SB(b, h) ((4 + (b) * 2 + (h)) * HTB)
#define PG8_STAGE(bufoff, gbase, voff) do { _Pragma("unroll") for (int _i = 0; _i < 2; ++_i) \
        __builtin_amdgcn_global_load_lds((const unsigned*)((const char*)(gbase) + (voff)[_i]), (PG8_LAS unsigned*)(lds + (bufoff) + ldsw + _i * 8192), 16, 0, 0); } while (0)
#define PG8_LDA(dst, b, h) do { _Pragma("unroll") for (int m = 0; m < 4; ++m) _Pragma("unroll") for (int k = 0; k < 2; ++k) dst[m][k] = *(const PG8_LAS bf16x8*)(lds + PG8_SA(b, h) + aoff + m * 2048 + k * 1024); } while (0)
#define PG8_LDB(dst, b, h) do { _Pragma("unroll") for (int n = 0; n < 2; ++n) _Pragma("unroll") for (int k = 0; k < 2; ++k) dst[n][k] = *(const PG8_LAS bf16x8*)(lds + PG8_SB(b, h) + boff + n * 2048 + k * 1024); } while (0)
#define PG8_MMA(ai, bj, At, Bt) do { __builtin_amdgcn_s_setprio(1); _Pragma("unroll") for (int m = 0; m < 4; ++m) _Pragma("unroll") for (int n = 0; n < 2; ++n) _Pragma("unroll") for (int k = 0; k < 2; ++k) \
        acc[ai][bj][m][n] = __builtin_amdgcn_mfma_f32_16x16x32_bf16(Bt[n][k], At[m][k], acc[ai][bj][m][n], 0, 0, 0); __builtin_amdgcn_s_setprio(0); } while (0)
#define PG8_WAIT_V(n) asm volatile("s_waitcnt vmcnt(" #n ")" ::: "memory")
#define PG8_WAIT_L(n) asm volatile("s_waitcnt lgkmcnt(" #n ")" ::: "memory")
#define PG8_BAR __builtin_amdgcn_s_barrier()
#define PG8_SCHED __builtin_amdgcn_sched_barrier(0)
    Unit cur, nxt; int ui = 0;
    if (!S.next(0, cur)) return;
    f32x4 acc[2][2][4][2];
#pragma unroll
    for (int a = 0; a < 2; ++a)
#pragma unroll
        for (int b = 0; b < 2; ++b)
#pragma unroll
            for (int m = 0; m < 4; ++m)
#pragma unroll
                for (int n = 0; n < 2; ++n) acc[a][b][m][n] = (f32x4){0.f, 0.f, 0.f, 0.f};
    bf16x8 At[4][2], B0[2][2], B1[2][2];
    const char* cA = (const char*)g.A + (size_t)cur.pm * tstep; const char* cB = (const char*)g.Bt + (size_t)cur.pn * tstep;
    S.a_ready(cur);
    if constexpr (SP2) {
        PG8_STAGE(PG8_SB(0, 0), cB, voffB); PG8_STAGE(PG8_SB(0, 1), cB + hstep, voffB); PG8_STAGE(PG8_SA(0, 0), cA, voffA); PG8_STAGE(PG8_SA(0, 1), cA + hstep, voffA);
        if constexpr (Epi::INIT_ACC) E.init(acc, cur, wr, wc, fr, fq);
        if (wr == 1) PG8_BAR;
        PG8_WAIT_V(2); PG8_BAR;
        PG8_STAGE(PG8_SB(1, 0), cB + kstep, voffB); PG8_STAGE(PG8_SA(1, 0), cA + kstep, voffA); PG8_STAGE(PG8_SB(1, 1), cB + hstep + kstep, voffB);
        PG8_WAIT_V(6); PG8_BAR;
    } else {
        PG8_STAGE(PG8_SB(0, 0), cB, voffB); PG8_STAGE(PG8_SA(0, 0), cA, voffA); PG8_STAGE(PG8_SB(0, 1), cB + hstep, voffB); PG8_STAGE(PG8_SA(0, 1), cA + hstep, voffA);
        if (wr == 1) PG8_BAR;
        PG8_WAIT_V(4); PG8_BAR;
        PG8_STAGE(PG8_SB(1, 0), cB + kstep, voffB); PG8_STAGE(PG8_SA(1, 0), cA + kstep, voffA); PG8_STAGE(PG8_SB(1, 1), cB + hstep + kstep, voffB);
        PG8_WAIT_V(6); PG8_BAR;
    }
    for (;;) {
        const bool has_next = S.next(ui + 1, nxt);
        const char* nA = has_next ? (const char*)g.A + (size_t)nxt.pm * tstep : cA; const char* nB = has_next ? (const char*)g.Bt + (size_t)nxt.pn * tstep : cB;
        for (int t = 0; t < nt; t += 2) {
            const bool last = (t == nt - 2);
            const char* a1 = cA + (size_t)(t + 1) * kstep;
            const char* a2 = last ? nA : cA + (size_t)(t + 2) * kstep; const char* b2 = last ? nB : cB + (size_t)(t + 2) * kstep;
            const char* a3 = a2 + kstep; const char* b3 = b2 + kstep;
            if (last && has_next) S.a_ready(nxt);
            if constexpr (SP2) {
            PG8_LDB(B0, 0, 0); PG8_LDB(B1, 0, 1); PG8_SCHED; PG8_LDA(At, 0, 0); PG8_STAGE(PG8_SA(1, 1), a1 + hstep, voffA);
            PG8_WAIT_V(8); PG8_WAIT_L(0); PG8_BAR; PG8_MMA(0, 0, At, B0); PG8_MMA(0, 1, At, B1); PG8_BAR; PG8_SCHED;
            PG8_LDA(At, 0, 1); PG8_STAGE(PG8_SB(0, 0), b2, voffB); PG8_STAGE(PG8_SB(0, 1), b2 + hstep, voffB); PG8_STAGE(PG8_SA(0, 0), a2, voffA);
            PG8_WAIT_V(8); PG8_WAIT_L(0); PG8_BAR; PG8_MMA(1, 0, At, B0); PG8_MMA(1, 1, At, B1); PG8_BAR; PG8_SCHED;
            PG8_LDB(B0, 1, 0); PG8_LDB(B1, 1, 1); PG8_SCHED; PG8_LDA(At, 1, 0); PG8_STAGE(PG8_SA(0, 1), a2 + hstep, voffA);
            PG8_WAIT_V(8); PG8_WAIT_L(0); PG8_BAR; PG8_MMA(0, 0, At, B0); PG8_MMA(0, 1, At, B1); PG8_BAR; PG8_SCHED;
            PG8_LDA(At, 1, 1); PG8_STAGE(PG8_SB(1, 0), b3, voffB); PG8_STAGE(PG8_SB(1, 1), b3 + hstep, voffB); PG8_STAGE(PG8_SA(1, 0), a3, voffA);
            PG8_WAIT_V(8); PG8_WAIT_L(0); PG8_BAR; PG8_MMA(1, 0, At, B0); PG8_MMA(1, 1, At, B1); PG8_BAR; PG8_SCHED;
            } else {
            PG8_LDB(B0, 0, 0); PG8_SCHED; PG8_LDA(At, 0, 0); PG8_STAGE(PG8_SA(1, 1), a1 + hstep, voffA);
            PG8_WAIT_L(8); PG8_BAR; PG8_WAIT_L(0); PG8_MMA(0, 0, At, B0); PG8_BAR; PG8_SCHED;
            PG8_LDB(B1, 0, 1); PG8_STAGE(PG8_SB(0, 0), b2, voffB);
            PG8_BAR; PG8_WAIT_L(0); PG8_MMA(0, 1, At, B1); PG8_BAR;
            PG8_LDA(At, 0, 1); PG8_STAGE(PG8_SA(0, 0), a2, voffA);
            PG8_BAR; PG8_WAIT_L(0); PG8_MMA(1, 0, At, B0); PG8_BAR; PG8_SCHED;
            PG8_STAGE(PG8_SB(0, 1), b2 + hstep, voffB);
            PG8_WAIT_V(6); PG8_BAR; PG8_MMA(1, 1, At, B1); PG8_BAR;
            PG8_LDB(B0, 1, 0); PG8_SCHED; PG8_LDA(At, 1, 0); PG8_STAGE(PG8_SA(0, 1), a2 + hstep, voffA);
            PG8_WAIT_L(8); PG8_BAR; PG8_WAIT_L(0); PG8_MMA(0, 0, At, B0); PG8_BAR; PG8_SCHED;
            PG8_LDB(B1, 1, 1); PG8_STAGE(PG8_SB(1, 0), b3, voffB);
            PG8_BAR; PG8_WAIT_L(0); PG8_MMA(0, 1, At, B1); PG8_BAR;
            PG8_LDA(At, 1, 1); PG8_STAGE(PG8_SA(1, 0), a3, voffA);
            PG8_BAR; PG8_WAIT_L(0); PG8_MMA(1, 0, At, B0); PG8_BAR; PG8_SCHED;
            PG8_STAGE(PG8_SB(1, 1), b3 + hstep, voffB);
            PG8_WAIT_V(6); PG8_BAR; PG8_MMA(1, 1, At, B1); PG8_BAR;
            }
        }
        if constexpr (ALIGN_EPI) { if (wr == 0) PG8_BAR; }
        if constexpr (!Epi::AFTER_DRAIN) { E(acc, cur, wr, wc, fr, fq); S.done(cur); }
        if (!has_next) break;
#pragma unroll
        for (int a = 0; a < 2; ++a)
#pragma unroll
            for (int b = 0; b < 2; ++b)
#pragma unroll
                for (int m = 0; m < 4; ++m)
#pragma unroll
                    for (int n = 0; n < 2; ++n) acc[a][b][m][n] = (f32x4){0.f, 0.f, 0.f, 0.f};
        if constexpr (Epi::INIT_ACC) E.init(acc, nxt, wr, wc, fr, fq);
        cur = nxt; cA = nA; cB = nB; ++ui;
        if constexpr (ALIGN_EPI) { if (wr == 1) PG8_BAR; }
    }
    PG8_WAIT_V(0);
    if constexpr (!ALIGN_EPI) { if (wr == 0) PG8_BAR; }
    PG8_BAR;
    if constexpr (Epi::AFTER_DRAIN) { E.fused(acc, cur, wr, wc, fr, fq, lds, wid, lane); S.done(cur); }
#undef PG8_SA
#undef PG8_SB
#undef PG8_STAGE
#undef PG8_LDA
#undef PG8_LDB
#undef PG8_MMA
#undef PG8_WAIT_V
#undef PG8_WAIT_L
#undef PG8_BAR
#undef PG8_SCHED
}
}
namespace attn_body {
using bf16=__hip_bfloat16;
using bf16x8=__attribute__((ext_vector_type(8)))short;
using s16x4=__attribute__((ext_vector_type(4)))short;
using f32x16=__attribute__((ext_vector_type(16)))float;
using u32x4=__attribute__((ext_vector_type(4)))unsigned;
constexpr int BATCH=2,NHEAD=8,SEQ=8192,D=64,QP=2048,KP=128,VP=128,OP=1024;
constexpr int NW=8,QBLK=32,QB=QBLK*NW,KVBLK=64,NQB=SEQ/QB;
constexpr int ATTN_UNIT_ROWS=QB;
__device__ __forceinline__ int crow(int r,int hi){return (r&3)+8*(r>>2)+4*hi;}
#define SBAR() __builtin_amdgcn_sched_barrier(0)
__device__ __forceinline__ void cmask(f32x16&p0,f32x16&p1,int jb,int qrel,int hi){
  const float NEG=-INFINITY; int kb=64*jb+4*hi;
  #pragma unroll
  for(int r=0;r<16;++r){int kv=kb+(r&3)+8*(r>>2); if(kv>qrel)p0[r]=NEG; if(kv+32>qrel)p1[r]=NEG;}
}

constexpr int NSLOT=3, SLOTB=8192;
constexpr int LDS_K=0, LDS_V=NSLOT*SLOTB, LDS_WS=2*NSLOT*SLOTB, LDS_OST=LDS_WS+NW*64*4, LDS_BYTES=LDS_OST+NW*4096;
constexpr float C2=0.125f*1.4426950408889634f;
__device__ __forceinline__ void glds16(const void*gsrc,unsigned lds_dst){unsigned keep;
  asm volatile("s_mov_b32 %0, m0\n\ts_mov_b32 m0, %2\n\ts_nop 0\n\tglobal_load_lds_dwordx4 %1, off\n\ts_mov_b32 m0, %0":"=&s"(keep):"v"(gsrc),"s"(lds_dst):"memory");}
__device__ __forceinline__ float max3f(float a,float b,float c){float r;asm("v_max3_f32 %0, %1, %2, %3":"=v"(r):"v"(a),"v"(b),"v"(c));return r;}
__device__ __forceinline__ float max2f(float a,float b){float r;asm("v_max_f32_e32 %0, %1, %2":"=v"(r):"v"(a),"v"(b));return r;}
__device__ __forceinline__ float fadd_s(float a,float b){float r;asm("v_add_f32_e32 %0, %1, %2":"=v"(r):"v"(a),"v"(b));return r;}
__device__ __forceinline__ float fsub_s(float a,float b){float r;asm("v_sub_f32_e32 %0, %1, %2":"=v"(r):"v"(a),"v"(b));return r;}
typedef float f32x2_t __attribute__((ext_vector_type(2))); typedef __bf16 bf16x2_t __attribute__((ext_vector_type(2)));
__device__ __forceinline__ unsigned cvtpk_s(float lo,float hi){f32x2_t v={lo,hi};bf16x2_t b=__builtin_convertvector(v,bf16x2_t);return __builtin_bit_cast(unsigned,b);}
#define WAIT_BAR(N) asm volatile("s_waitcnt vmcnt(" #N ") lgkmcnt(0)\n\ts_barrier":::"memory")

__device__ __forceinline__ void qkt(f32x16&p0,f32x16&p1,const char*Kslot,const bf16x8*qr,const f32x16&negm,int r32,int hi){
  const char*kb=Kslot+hi*1024+r32*16;
  #pragma unroll
  for(int d0=0;d0<4;++d0){
    const bf16x8 b0=*reinterpret_cast<const bf16x8*>(kb+d0*2048);
    const bf16x8 b1=*reinterpret_cast<const bf16x8*>(kb+d0*2048+512);
    if(d0==0){p0=__builtin_amdgcn_mfma_f32_32x32x16_bf16(b0,qr[0],negm,0,0,0);p1=__builtin_amdgcn_mfma_f32_32x32x16_bf16(b1,qr[0],negm,0,0,0);}
    else{p0=__builtin_amdgcn_mfma_f32_32x32x16_bf16(b0,qr[d0],p0,0,0,0);p1=__builtin_amdgcn_mfma_f32_32x32x16_bf16(b1,qr[d0],p1,0,0,0);}}
}
typedef __attribute__((address_space(3))) const char* lds_cptr;
typedef short v4i16_t __attribute__((ext_vector_type(4)));
__device__ __forceinline__ void kload8(bf16x8*kf,lds_cptr kp){
  kf[0]=*(const __attribute__((address_space(3))) bf16x8*)(kp);      kf[1]=*(const __attribute__((address_space(3))) bf16x8*)(kp+512);
  kf[2]=*(const __attribute__((address_space(3))) bf16x8*)(kp+2048); kf[3]=*(const __attribute__((address_space(3))) bf16x8*)(kp+2560);
  kf[4]=*(const __attribute__((address_space(3))) bf16x8*)(kp+4096); kf[5]=*(const __attribute__((address_space(3))) bf16x8*)(kp+4608);
  kf[6]=*(const __attribute__((address_space(3))) bf16x8*)(kp+6144); kf[7]=*(const __attribute__((address_space(3))) bf16x8*)(kp+6656);
}
__device__ __forceinline__ void kload2(bf16x8*kf,lds_cptr kp,int j){ kf[2*j]=*(const __attribute__((address_space(3))) bf16x8*)(kp+j*2048); kf[2*j+1]=*(const __attribute__((address_space(3))) bf16x8*)(kp+j*2048+512); }
__device__ __forceinline__ s16x4 vtr(lds_cptr p){ return __builtin_bit_cast(s16x4,__builtin_amdgcn_ds_read_tr16_b64_v4i16((__attribute__((address_space(3))) v4i16_t*)p)); }
__device__ __forceinline__ float rowmax(const f32x16&p0,const f32x16&p1){
  float a=max3f(p0[0],p0[1],p1[0]),b=max3f(p0[2],p0[3],p1[1]);a=max3f(a,p1[2],p1[3]);
  #pragma unroll
  for(int r=4;r<16;r+=4){a=max3f(a,p0[r],p0[r+1]);b=max3f(b,p0[r+2],p0[r+3]);a=max3f(a,p1[r],p1[r+1]);b=max3f(b,p1[r+2],p1[r+3]);}
  const float m=max2f(a,b);
  auto rr=__builtin_amdgcn_permlane32_swap(__float_as_uint(m),__float_as_uint(m),false,false);
  return max2f(__uint_as_float(rr[0]),__uint_as_float(rr[1]));
}
__device__ __forceinline__ void pv(f32x16*o,int vb,bf16x8 pa0,bf16x8 pa1,bf16x8 pa2,bf16x8 pa3){
  #pragma unroll
  for(int d0=0;d0<2;++d0){s16x4 lo[4],hi[4];
    #pragma unroll
    for(int ks=0;ks<4;++ks){
      asm volatile("ds_read_b64_tr_b16 %0,%1 offset:%c2":"=&v"(lo[ks]):"v"(vb),"i"(d0*4096+ks*1024):"memory");
      asm volatile("ds_read_b64_tr_b16 %0,%1 offset:%c2":"=&v"(hi[ks]):"v"(vb),"i"(d0*4096+ks*1024+512):"memory");}
    asm volatile("s_waitcnt lgkmcnt(0)":::"memory");SBAR();
    #define PK(k) (bf16x8){lo[k][0],lo[k][1],lo[k][2],lo[k][3],hi[k][0],hi[k][1],hi[k][2],hi[k][3]}
    o[d0]=__builtin_amdgcn_mfma_f32_32x32x16_bf16(pa0,PK(0),o[d0],0,0,0);
    o[d0]=__builtin_amdgcn_mfma_f32_32x32x16_bf16(pa1,PK(1),o[d0],0,0,0);
    o[d0]=__builtin_amdgcn_mfma_f32_32x32x16_bf16(pa2,PK(2),o[d0],0,0,0);
    o[d0]=__builtin_amdgcn_mfma_f32_32x32x16_bf16(pa3,PK(3),o[d0],0,0,0);
    #undef PK
  }
}

#ifndef ATTN_STORE16
#define ATTN_STORE16(p,v) (*(u32x4*)(p)=(v))
#endif
template<int THRL,bool TRACK> __device__ __forceinline__ void attn_unit(int b,int h,int kvh,int qb,const bf16*Q,const bf16*__restrict__ K,const bf16*__restrict__ V,bf16*O,const float*gq,char*shm,const int tid){
  const int lane=tid&63,r32=lane&31,hi=lane>>5; const int wid=__builtin_amdgcn_readfirstlane(tid>>6);
  const long rowbase=(long)b*SEQ; const int q0=qb*QB;
  const bf16*Qw=Q+(rowbase+q0+wid*QBLK)*QP+h*D;
  const bf16*Kh=K+(long)(b*2+kvh)*(SEQ/KVBLK)*4096,*Vh=V+(long)(b*2+kvh)*(SEQ/KVBLK)*4096;
  const unsigned lds0=(unsigned)(uintptr_t)shm;
  float*wsf=(float*)(shm+LDS_WS)+wid*64;
  const bf16*ksrc=Kh+wid*512+lane*8;
  const bf16*vsrc=Vh+wid*512+lane*8;
  const unsigned kdst=lds0+LDS_K+wid*1024, vdst=lds0+LDS_V+wid*1024;
  #define DMA_K(t,slot) glds16(ksrc+(long)(t)*4096,(unsigned)__builtin_amdgcn_readfirstlane(kdst+(slot)))
  #define DMA_V(t,slot) glds16(vsrc+(long)(t)*4096,(unsigned)__builtin_amdgcn_readfirstlane(vdst+(slot)))
  const int vb0=(int)(lds0+LDS_V)+((lane>>4)&1)*32+(lane&3)*8+(4*hi+((lane&15)>>2))*64;
  const char*Kbase=shm+LDS_K; bf16x8 kf[8];
  const lds_cptr shm3=(lds_cptr)shm; const lds_cptr kp0=shm3+LDS_K+hi*1024+r32*16; const lds_cptr vp0=shm3+LDS_V+((lane>>4)&1)*32+(lane&3)*8+(4*hi+((lane&15)>>2))*64;
  const int NT=SEQ/KVBLK;
  DMA_K(0,0);DMA_V(0,0);DMA_K(1,SLOTB);
  bf16x8 qr[4];
  { u32x4 raw[4];
    #pragma unroll
    for(int d0=0;d0<4;++d0)raw[d0]=*reinterpret_cast<const u32x4*>(&Qw[(long)r32*QP+d0*16+hi*8]);
    float ss=0.f;
    #pragma unroll
    for(int d0=0;d0<4;++d0){
      #pragma unroll
      for(int w=0;w<4;++w){ const float lo=__uint_as_float(raw[d0][w]<<16), hh=__uint_as_float(raw[d0][w]&0xffff0000u); ss+=lo*lo+hh*hh; } }
    { auto rr=__builtin_amdgcn_permlane32_swap(__float_as_uint(ss),__float_as_uint(ss),false,false); ss=__uint_as_float(rr[0])+__uint_as_float(rr[1]); }
    const float rs=__builtin_amdgcn_rsqf(ss*(1.0f/64.0f)+1e-6f)*C2;
    const int tq=q0+wid*QBLK+r32;
    #pragma unroll
    for(int part=0;part<2;++part){
      const float pos=(float)(part==0?(tq>>6):(tq&63));
      float y0[8],y1[8];
      #pragma unroll
      for(int e=0;e<8;++e){
        const float inv=__builtin_amdgcn_exp2f(-(float)(8*hi+e)*(13.287712379549449f/16.0f));
        const float ang=pos*inv; const float c=__cosf(ang), sn=__sinf(ang);
        const unsigned w0=raw[2*part][e>>1], w1=raw[2*part+1][e>>1];
        const float a0=((e&1)?__uint_as_float(w0&0xffff0000u):__uint_as_float(w0<<16))*rs*gq[32*part+8*hi+e];
        const float a1=((e&1)?__uint_as_float(w1&0xffff0000u):__uint_as_float(w1<<16))*rs*gq[32*part+16+8*hi+e];
        y0[e]=a0*c-a1*sn; y1[e]=a0*sn+a1*c; }
      u32x4 wa,wb;
      #pragma unroll
      for(int w=0;w<4;++w){ wa[w]=cvtpk_s(y0[2*w],y0[2*w+1]); wb[w]=cvtpk_s(y1[2*w],y1[2*w+1]); }
      qr[2*part]=__builtin_bit_cast(bf16x8,wa); qr[2*part+1]=__builtin_bit_cast(bf16x8,wb);
      asm volatile("":"+v"(qr[2*part]),"+v"(qr[2*part+1])); SBAR(); } }
  float mhat=0.f,l_reg=0.f;f32x16 o[2],negm; { float zf=0.f; asm volatile("":"+v"(zf));
    _Pragma("unroll") for(int r=0;r<16;++r){o[0][r]=zf;o[1][r]=zf;negm[r]=zf;} } asm volatile("":"+v"(negm));

  #define CMASK(P0,P1,t) do{}while(0)
  bool resc=false;
  #define START(P0,P1) do{ const float rm=rowmax(P0,P1); resc=false; \
    { const float dl=rm; mhat=fadd_s(mhat,dl); \
      _Pragma("unroll") for(int r=0;r<16;++r){P0[r]=fsub_s(P0[r],dl);P1[r]=fsub_s(P1[r],dl);} \
      _Pragma("unroll") for(int r=0;r<16;++r)negm[r]=-mhat; asm volatile("":"+v"(negm)); } \
    _Pragma("unroll") for(int r=0;r<16;++r)P0[r]=__builtin_amdgcn_exp2f(P0[r]); }while(0)
  #define RESC() do{ if(resc){ asm volatile("s_waitcnt lgkmcnt(0)":::"memory"); \
      _Pragma("unroll") for(int d_=0;d_<2;++d_) _Pragma("unroll") for(int r=0;r<16;++r)o[d_][r]*=wsf[crow(r,hi)]; } }while(0)
  f32x16 pA0,pA1,pB0,pB1;
  int sl_prev=0,sl_cur=0,sl_next=SLOTB;
  #define ROT() do{sl_prev=sl_cur;sl_cur=sl_next;sl_next=(sl_next==(NSLOT-1)*SLOTB)?0:sl_next+SLOTB;}while(0)
  DMA_K(2,2*SLOTB);
  WAIT_BAR(3);
  qkt(pA0,pA1,Kbase,qr,negm,r32,hi);asm volatile("s_nop 15\n\ts_nop 7":"+v"(pA0),"+v"(pA1));CMASK(pA0,pA1,0);
  START(pA0,pA1);
  _Pragma("unroll") for(int r=0;r<16;++r)pA1[r]=__builtin_amdgcn_exp2f(pA1[r]);
  WAIT_BAR(0);
  DMA_K(3,0);DMA_V(1,SLOTB);
  ROT();
  kload8(kf,kp0+sl_cur);
  WAIT_BAR(2);
  s16x4 vlo[8],vhi[8]; u32x4 pw0,pw1,pw2,pw3;
  #define PKW(P,B) cvtpk_s(P[B],P[B+1])
  #define PAF(k) __builtin_bit_cast(bf16x8,pw##k)
  #define VFR(i) (bf16x8){vlo[i][0],vlo[i][1],vlo[i][2],vlo[i][3],vhi[i][0],vhi[i][1],vhi[i][2],vhi[i][3]}
  #define PIN(x) asm volatile("":"+v"(x))
  #define MX3(a,b,c) __builtin_fmaxf(__builtin_fmaxf((a),(b)),(c))
  #define GAPA(MF,A0,A1,A2,A3,W0,W1,PW) do{ MF; sacc+=A0; sacc+=A1; sacc+=A2; sacc+=A3; PIN(sacc); W0; W1; PIN(PW); SBAR(); }while(0)
  #define EX(v) __builtin_amdgcn_exp2f(v)
  #define GAPB(MF,X,B) do{ MF; X[B]=EX(X[B]); X[B+1]=EX(X[B+1]); X[B+2]=EX(X[B+2]); X[B+3]=EX(X[B+3]); PIN(X); SBAR(); }while(0)
  #define VRD(i) do{ vlo[i]=vtr(vp_+(((i)>>2)*4096+((i)&3)*1024)); vhi[i]=vtr(vp_+(((i)>>2)*4096+((i)&3)*1024+512)); }while(0)
  #define KRD(G,j) do{ if(G){ kload2(kf,kp0+sl_next,j); SBAR(); } }while(0)
  #define STEP(C0,C1,P0,P1,t,GK,GV,GL) do{ SBAR(); \
    const lds_cptr vp_=vp0+sl_prev; \
    VRD(0); SBAR(); float sacc=(P0[0]+P0[1]); \
    GAPA(C0=__builtin_amdgcn_mfma_f32_32x32x16_bf16(kf[0],qr[0],negm,0,0,0), P0[2],P0[3],P0[4],P0[5],     pw0[0]=PKW(P0,0), pw0[1]=PKW(P0,2), pw0); \
    VRD(4); SBAR(); GAPA(C1=__builtin_amdgcn_mfma_f32_32x32x16_bf16(kf[1],qr[0],negm,0,0,0), P0[6],P0[7],P0[8],P0[9],     pw0[2]=PKW(P0,4), pw0[3]=PKW(P0,6), pw0); \
    VRD(1); SBAR(); GAPA(C0=__builtin_amdgcn_mfma_f32_32x32x16_bf16(kf[2],qr[1],C0,0,0,0),   P0[10],P0[11],P0[12],P0[13], pw1[0]=PKW(P0,8), pw1[1]=PKW(P0,10), pw1); \
    VRD(5); SBAR(); GAPA(C1=__builtin_amdgcn_mfma_f32_32x32x16_bf16(kf[3],qr[1],C1,0,0,0),   P0[14],P0[15],P1[0],P1[1],   pw1[2]=PKW(P0,12),pw1[3]=PKW(P0,14), pw1); \
    VRD(2); SBAR(); GAPA(C0=__builtin_amdgcn_mfma_f32_32x32x16_bf16(kf[4],qr[2],C0,0,0,0),   P1[2],P1[3],P1[4],P1[5],     pw2[0]=PKW(P1,0), pw2[1]=PKW(P1,2), pw2); \
    VRD(6); SBAR(); GAPA(C1=__builtin_amdgcn_mfma_f32_32x32x16_bf16(kf[5],qr[2],C1,0,0,0),   P1[6],P1[7],P1[8],P1[9],     pw2[2]=PKW(P1,4), pw2[3]=PKW(P1,6), pw2); \
    VRD(3); SBAR(); GAPA(C0=__builtin_amdgcn_mfma_f32_32x32x16_bf16(kf[6],qr[3],C0,0,0,0),   P1[10],P1[11],P1[12],P1[13], pw3[0]=PKW(P1,8), pw3[1]=PKW(P1,10), pw3); \
    VRD(7); SBAR(); GAPA(C1=__builtin_amdgcn_mfma_f32_32x32x16_bf16(kf[7],qr[3],C1,0,0,0),   P1[14],P1[15],0.f,0.f,       pw3[2]=PKW(P1,12),pw3[3]=PKW(P1,14), pw3); \
    l_reg+=sacc; \
    if(GK){DMA_K((t)+3,sl_cur);} if(GV){DMA_V((t)+1,sl_next);} \
    CMASK(C0,C1,t); \
    if(TRACK){ float a=MX3(C0[0],C0[1],C1[0]),b=MX3(C0[2],C0[3],C1[1]); a=MX3(a,C1[2],C1[3]); \
      _Pragma("unroll") for(int r=4;r<16;r+=4){a=MX3(a,C0[r],C0[r+1]);b=MX3(b,C0[r+2],C0[r+3]);a=MX3(a,C1[r],C1[r+1]);b=MX3(b,C1[r+2],C1[r+3]);} \
      float rm=__builtin_fmaxf(a,b); { auto rr=__builtin_amdgcn_permlane32_swap(__float_as_uint(rm),__float_as_uint(rm),false,false); rm=__builtin_fmaxf(__uint_as_float(rr[0]),__uint_as_float(rr[1])); } \
      resc=false; \
      if(__builtin_expect(__any(rm>(float)THRL),0)){ const float dl=__builtin_fmaxf(rm,0.f); mhat+=dl; \
        _Pragma("unroll") for(int r=0;r<16;++r){C0[r]-=dl;C1[r]-=dl;} \
        _Pragma("unroll") for(int r=0;r<16;++r)negm[r]=-mhat; asm volatile("":"+v"(negm)); \
        const float f=__builtin_amdgcn_exp2f(-dl); l_reg*=f; if(hi==0)wsf[r32]=f; resc=true; } } \
    SBAR(); \
    GAPB(o[0]=__builtin_amdgcn_mfma_f32_32x32x16_bf16(PAF(0),VFR(0),o[0],0,0,0), C0,0); \
    GAPB(o[1]=__builtin_amdgcn_mfma_f32_32x32x16_bf16(PAF(0),VFR(4),o[1],0,0,0), C0,4); \
    KRD(GL,0); GAPB(o[0]=__builtin_amdgcn_mfma_f32_32x32x16_bf16(PAF(1),VFR(1),o[0],0,0,0), C0,8); \
    KRD(GL,1); GAPB(o[1]=__builtin_amdgcn_mfma_f32_32x32x16_bf16(PAF(1),VFR(5),o[1],0,0,0), C0,12); \
    KRD(GL,2); GAPB(o[0]=__builtin_amdgcn_mfma_f32_32x32x16_bf16(PAF(2),VFR(2),o[0],0,0,0), C1,0); \
    KRD(GL,3); GAPB(o[1]=__builtin_amdgcn_mfma_f32_32x32x16_bf16(PAF(2),VFR(6),o[1],0,0,0), C1,4); \
    GAPB(o[0]=__builtin_amdgcn_mfma_f32_32x32x16_bf16(PAF(3),VFR(3),o[0],0,0,0), C1,8); \
    GAPB(o[1]=__builtin_amdgcn_mfma_f32_32x32x16_bf16(PAF(3),VFR(7),o[1],0,0,0), C1,12); \
    }while(0)
  int t=1;
  #undef CMASK
  #define CMASK(P0,P1,t) do{}while(0)
  for(;t+5<NT;t+=2){
    STEP(pB0,pB1,pA0,pA1,t,true,true,true);     WAIT_BAR(2); RESC(); ROT();
    STEP(pA0,pA1,pB0,pB1,t+1,true,true,true);   WAIT_BAR(2); RESC(); ROT();
  }
  #undef CMASK
  #define CMASK(P0,P1,t) do{}while(0)
  #define ENDW(tt) do{ if((tt)+3<NT){WAIT_BAR(2);} else if((tt)+2<NT){WAIT_BAR(1);} else {WAIT_BAR(0);} }while(0)
  for(;t+1<NT;t+=2){
    STEP(pB0,pB1,pA0,pA1,t,(t+3<NT),(t+1<NT),(t+1<NT));       ENDW(t);   RESC(); ROT();
    STEP(pA0,pA1,pB0,pB1,t+1,(t+4<NT),(t+2<NT),(t+2<NT));     ENDW(t+1); RESC(); ROT();
  }
  STEP(pB0,pB1,pA0,pA1,NT-1,false,false,false); RESC();
  { float sacc=pB0[0]+pB0[1]; _Pragma("unroll") for(int r=2;r<16;++r)sacc+=pB0[r]; _Pragma("unroll") for(int r=0;r<16;++r)sacc+=pB1[r]; l_reg+=sacc;
    pw0=(u32x4){PKW(pB0,0),PKW(pB0,2),PKW(pB0,4),PKW(pB0,6)};pw1=(u32x4){PKW(pB0,8),PKW(pB0,10),PKW(pB0,12),PKW(pB0,14)};pw2=(u32x4){PKW(pB1,0),PKW(pB1,2),PKW(pB1,4),PKW(pB1,6)};pw3=(u32x4){PKW(pB1,8),PKW(pB1,10),PKW(pB1,12),PKW(pB1,14)};
    SBAR(); pv(o,vb0+sl_cur,PAF(0),PAF(1),PAF(2),PAF(3)); }
  #undef PKW
  #undef PAF
  #undef VFR
  #undef PIN
  #undef MX3
  #undef GAPA
  #undef GAPB
  #undef EX
  #undef VRD
  #undef KRD
  #undef STEP
  #undef ENDW
  {auto rr=__builtin_amdgcn_permlane32_swap(__float_as_uint(l_reg),__float_as_uint(l_reg),false,false);l_reg=__uint_as_float(rr[0])+__uint_as_float(rr[1]);}
  if(hi==0)wsf[32+r32]=l_reg;asm volatile("s_waitcnt lgkmcnt(0)":::"memory");
  float rli[16];
  #pragma unroll
  for(int r=0;r<16;++r)rli[r]=__builtin_amdgcn_rcpf(wsf[32+crow(r,hi)]);
  bf16*Ow=O+(rowbase+q0+wid*QBLK)*OP+h*D;
  { bf16*stg=(bf16*)(shm+LDS_OST)+wid*2048;
    #pragma unroll
    for(int r=0;r<16;++r){const int orow=crow(r,hi);
      #pragma unroll
      for(int d0=0;d0<2;++d0)stg[orow*64+d0*32+r32]=__float2bfloat16(o[d0][r]*rli[r]);}
    asm volatile("s_waitcnt lgkmcnt(0)":::"memory");
    #pragma unroll
    for(int i=0;i<4;++i){const int row=i*8+(lane>>3),ch=lane&7; const u32x4 v=*(const u32x4*)(stg+row*64+ch*8); ATTN_STORE16(Ow+(long)row*OP+ch*8,v);} }
  asm volatile("s_waitcnt lgkmcnt(0)\n\ts_barrier":::"memory");
  #undef DMA_K
  #undef DMA_V
  #undef CMASK
  #undef START
  #undef RESC
  #undef ROT
}
constexpr int ATTN_LDS_BYTES=LDS_BYTES;
struct AttnTensors { const bf16* Q; const bf16* K; const bf16* V; bf16* O; const float* gq; };
struct AttnUnit { int b, h, kvh, qb; };
struct StaticOrder {
  int vcu, G;
  __device__ __forceinline__ StaticOrder(int grid,int vcu_):vcu(vcu_),G(grid){}
  __device__ __forceinline__ bool next(int i,AttnUnit&u)const{ const int U=i*G+vcu; if(U>=512)return false; const int grp=(U>>6)&3, idx=(U&63)|((U>>8)<<6);
    u.b=grp>>1; u.kvh=grp&1; u.h=(grp&1)*4+(idx>>5); u.qb=idx&31; return true; }
};
template<class Sched,int THRL,bool TRACK> __device__ __forceinline__ void attn_phase(char*lds,const AttnTensors&T,const Sched&S,const int tid){
  AttnUnit u;
  for(int i=0;S.next(i,u);++i){ attn_unit<THRL,TRACK>(u.b,u.h,u.kvh,u.qb,T.Q,T.K,T.V,T.O,T.gq,lds,tid); }
}
#undef SBAR
#undef WAIT_BAR
}
constexpr int NWAVES = 8;
constexpr int BATCH = 2, SEQ = 8192, DMODEL = 1024, MTOK = BATCH * SEQ, DEPTH = 4;
constexpr int PROJ_W = 2048, D_FF = 2816, D_FF2 = 5632;
constexpr int OFF_Q = 0, OFF_K = 512, OFF_V = 640, OFF_SU = 768, OFF_SV = 1024, OFF_CB = 1280, OFF_CC = 1536, OFF_CX = 1792;
constexpr float EPS = 1e-6f;
constexpr float QSCALE = 0.125f * 1.4426950408889634f;
constexpr size_t MiB = 1u << 20;
constexpr size_t WS_PART1 = 1 * MiB, WS_PART2 = 2 * MiB, WS_SGW = 3 * MiB;
constexpr size_t WS_WSET = 4 * MiB, WSET_BYTES = 23 * MiB;
constexpr size_t WO_WIN = 0, WO_WOUT = 4 * MiB, WO_WUP = 6 * MiB, WO_WDOWN = 17 * MiB;
constexpr size_t WS_XB = 50 * MiB;
constexpr size_t WS_PRAW = 82 * MiB, WS_Q = 146 * MiB, WS_K = 162 * MiB, WS_V = 166 * MiB;
constexpr size_t WS_ACT = 82 * MiB;
constexpr size_t WS_MIX = 170 * MiB;
constexpr size_t WS_HALO = 202 * MiB;
constexpr size_t WS_END = 208 * MiB;
constexpr int LDS_BYTES = 153600;

#define LAS __attribute__((address_space(3)))
typedef unsigned short bf16;
typedef unsigned u32x4 __attribute__((ext_vector_type(4)));
typedef unsigned u32x2 __attribute__((ext_vector_type(2)));
typedef float f32x4 __attribute__((ext_vector_type(4)));
typedef short bf16x8 __attribute__((ext_vector_type(8)));

__device__ __forceinline__ unsigned pk2(float lo, float hi) { return pg8::cvt_pk_bf16(lo, hi); }
__device__ __forceinline__ float bf_lo(unsigned u) { return __uint_as_float(u << 16); }
__device__ __forceinline__ float bf_hi(unsigned u) { return __uint_as_float(u & 0xffff0000u); }
__device__ __forceinline__ float wave_sum(float v) {
#pragma unroll
    for (int o = 1; o < 64; o <<= 1) v += __shfl_xor(v, o);
    return v;
}
__device__ __forceinline__ int perm_up(int c) { const int v = c >= D_FF ? 1 : 0, cc = c - v * D_FF; return ((cc >> 7) << 8) + v * 128 + (cc & 127); }
__device__ __forceinline__ int perm_in(int c) { if (c < 512 || c >= 768) return c; const int oc = c - 512, hl = oc >> 6, d = oc & 63; return 512 + (d >> 5) * 128 + hl * 32 + (d & 31); }
__device__ __forceinline__ void transpose_item(const float* W, int K, int N, bf16* WT, const float* g, LAS float* scr, int item, int lane, int permup) {
    const int nblk = N / 32, kb = item / nblk, nb = item % nblk, k0 = 64 * kb, n0 = 32 * nb;
    float wv[32];
#pragma unroll
    for (int i = 0; i < 32; ++i) wv[i] = W[(size_t)(k0 + 2 * i + (lane >> 5)) * N + n0 + (lane & 31)];
#pragma unroll
    for (int i = 0; i < 32; ++i) { const int kk = 2 * i + (lane >> 5); float w = wv[i]; if (g) w *= g[k0 + kk]; scr[kk * 33 + (lane & 31)] = w; }
    asm volatile("s_waitcnt lgkmcnt(0)" ::: "memory");
    const int c = lane & 7;
#pragma unroll
    for (int j = 0; j < 4; ++j) { const int n = (lane >> 3) + 8 * j; const LAS float* s = scr + (8 * c) * 33 + n;
        u32x4 o; o.x = pk2(s[0 * 33], s[1 * 33]); o.y = pk2(s[2 * 33], s[3 * 33]); o.z = pk2(s[4 * 33], s[5 * 33]); o.w = pk2(s[6 * 33], s[7 * 33]);
        const int nrow = permup == 1 ? perm_up(n0 + n) : permup == 2 ? perm_in(n0 + n) : n0 + n;
        *(u32x4*)(WT + (size_t)nrow * K + k0 + 8 * c) = o; }
    asm volatile("s_waitcnt lgkmcnt(0)" ::: "memory");
}
struct ConvJob { const float* W; const float* g; bf16* WT; int K, N; int permup; };
__device__ __forceinline__ void convert_weights(const ConvJob& j0, const ConvJob& j1, const ConvJob& j2, const ConvJob& j3, int njobs, LAS float* scr, int gw, int NGW, int lane) {
    const int n0 = (j0.K / 64) * (j0.N / 32), n1 = njobs > 1 ? (j1.K / 64) * (j1.N / 32) : 0, n2 = njobs > 2 ? (j2.K / 64) * (j2.N / 32) : 0, n3 = njobs > 3 ? (j3.K / 64) * (j3.N / 32) : 0;
    const int total = n0 + n1 + n2 + n3;
    for (int it = gw; it < total; it += NGW) {
        if (it < n0) transpose_item(j0.W, j0.K, j0.N, j0.WT, j0.g, scr, it, lane, j0.permup);
        else if (it < n0 + n1) transpose_item(j1.W, j1.K, j1.N, j1.WT, j1.g, scr, it - n0, lane, j1.permup);
        else if (it < n0 + n1 + n2) transpose_item(j2.W, j2.K, j2.N, j2.WT, j2.g, scr, it - n0 - n1, lane, j2.permup);
        else transpose_item(j3.W, j3.K, j3.N, j3.WT, j3.g, scr, it - n0 - n1 - n2, lane, j3.permup);
    }
}
__device__ __forceinline__ u32x4 norm_rope8(u32x4 raw, const float* g, int s8, int t, float scale) {
    float x[8] = {bf_lo(raw.x), bf_hi(raw.x), bf_lo(raw.y), bf_hi(raw.y), bf_lo(raw.z), bf_hi(raw.z), bf_lo(raw.w), bf_hi(raw.w)};
    float ss = 0.f;
#pragma unroll
    for (int e = 0; e < 8; ++e) ss += x[e] * x[e];
    ss += __shfl_xor(ss, 1); ss += __shfl_xor(ss, 2); ss += __shfl_xor(ss, 4);
    const float rs = __builtin_amdgcn_rsqf(ss * (1.0f / 64.0f) + EPS);
    const f32x4 g0 = *(const f32x4*)(g + s8 * 8), g1 = *(const f32x4*)(g + s8 * 8 + 4);
    const float gg[8] = {g0[0], g0[1], g0[2], g0[3], g1[0], g1[1], g1[2], g1[3]};
    const float pos = (float)((s8 < 4) ? (t >> 6) : (t & 63));
    const float sgn = (s8 & 2) ? 1.0f : -1.0f;
    const int j0 = (s8 & 1) * 8;
    float o[8];
#pragma unroll
    for (int e = 0; e < 8; ++e) {
        const float xn = x[e] * rs * gg[e];
        const float other = __shfl_xor(xn, 2);
        const float inv = __builtin_amdgcn_exp2f(-(float)(j0 + e) * (13.287712379549449f / 16.0f));
        const float ang = pos * inv;
        const float c = __cosf(ang), sn = __sinf(ang);
        o[e] = (xn * c + sgn * other * sn) * scale;
    }
    u32x4 w; w.x = pk2(o[0], o[1]); w.y = pk2(o[2], o[3]); w.z = pk2(o[4], o[5]); w.w = pk2(o[6], o[7]); return w;
}
struct RowRaw { u32x4 cb, cc0, cc1, cc2, cx0, cx1, cx2; };
__device__ __forceinline__ RowRaw p1b_load(const bf16* praw, int m, int lane) {
    RowRaw R; const int t = m & (SEQ - 1), c = (lane & 31) * 8; const u32x4 z = (u32x4){0u, 0u, 0u, 0u};
    const bf16* pr = praw + (size_t)m * PROJ_W;
    R.cb = *(const u32x4*)(pr + OFF_CB + c); R.cc1 = *(const u32x4*)(pr + OFF_CC + c); R.cx1 = *(const u32x4*)(pr + OFF_CX + c);
    R.cc0 = t > 0 ? *(const u32x4*)(pr - PROJ_W + OFF_CC + c) : z; R.cx0 = t > 0 ? *(const u32x4*)(pr - PROJ_W + OFF_CX + c) : z;
    R.cc2 = t < SEQ - 1 ? *(const u32x4*)(pr + PROJ_W + OFF_CC + c) : z; R.cx2 = t < SEQ - 1 ? *(const u32x4*)(pr + PROJ_W + OFF_CX + c) : z;
    return R;
}
__device__ __forceinline__ void p1b_proc(const RowRaw& R, int m, bool valid, bf16* mix, const f32x4 (&wt)[3][2], int lane) {
    const int c = (lane & 31) * 8;
    float o[8];
#pragma unroll
    for (int h = 0; h < 4; ++h) {
        const float p0l = bf_lo(R.cc0[h]) * bf_lo(R.cx0[h]), p0h = bf_hi(R.cc0[h]) * bf_hi(R.cx0[h]);
        const float p1l = bf_lo(R.cc1[h]) * bf_lo(R.cx1[h]), p1h = bf_hi(R.cc1[h]) * bf_hi(R.cx1[h]);
        const float p2l = bf_lo(R.cc2[h]) * bf_lo(R.cx2[h]), p2h = bf_hi(R.cc2[h]) * bf_hi(R.cx2[h]);
        const int e0 = 2 * h, e1 = 2 * h + 1;
        o[e0] = bf_lo(R.cb[h]) * (wt[0][e0 >> 2][e0 & 3] * p0l + wt[1][e0 >> 2][e0 & 3] * p1l + wt[2][e0 >> 2][e0 & 3] * p2l);
        o[e1] = bf_hi(R.cb[h]) * (wt[0][e1 >> 2][e1 & 3] * p0h + wt[1][e1 >> 2][e1 & 3] * p1h + wt[2][e1 >> 2][e1 & 3] * p2h);
    }
    u32x4 w; w.x = pk2(o[0], o[1]); w.y = pk2(o[2], o[3]); w.z = pk2(o[4], o[5]); w.w = pk2(o[6], o[7]);
    if (valid) *(u32x4*)(mix + (size_t)m * 1024 + 768 + c) = w;
}
__device__ __forceinline__ void p1b_rows(const bf16* praw, bf16* mix, const float* convw, int gw, int NGW, int lane) {
    const int half = lane >> 5, c = (lane & 31) * 8;
    f32x4 wt[3][2];
#pragma unroll
    for (int k = 0; k < 3; ++k) { wt[k][0] = *(const f32x4*)(convw + k * 256 + c); wt[k][1] = *(const f32x4*)(convw + k * 256 + c + 4); }
    for (int k0 = 0; gw + k0 * NGW < MTOK; k0 += 8) {
        RowRaw R[4]; int mm[4]; bool ok[4];
#pragma unroll
        for (int i = 0; i < 4; ++i) { mm[i] = gw + (k0 + 2 * i + half) * NGW; ok[i] = mm[i] < MTOK; R[i] = p1b_load(praw, ok[i] ? mm[i] : gw, lane); }
#pragma unroll
        for (int i = 0; i < 4; ++i) p1b_proc(R[i], mm[i], ok[i], mix, wt, lane);
    }
}
__device__ __forceinline__ void sg_item(LAS unsigned char* lds, int item, const bf16* praw, const bf16* sgw, const float* sgb, const float* gsg, bf16* mix, int wave, int lane) {
    const int n = item >> 1, ph = item & 1;
    const size_t m0 = (size_t)n * 128;
    LAS float* psum = (LAS float*)lds;
    LAS bf16* vnT = (LAS bf16*)(lds + 4096);
    constexpr int VP = 136;
    const int fr = lane & 15, fq = lane >> 4, h = wave >> 1, cs = (wave & 1) * 32;
    bf16x8 afr[4][4]; u32x2 suv[4][2]; float biasv[4];
#pragma unroll
    for (int mb = 0; mb < 4; ++mb) {
#pragma unroll
        for (int kk = 0; kk < 4; ++kk) afr[mb][kk] = *(const bf16x8*)(sgw + ((size_t)(h * 128 + ph * 64 + mb * 16 + fr) * 128 + kk * 32 + fq * 8));
        const int p = ph * 64 + mb * 16 + fr; biasv[mb] = sgb[h * 128 + p];
#pragma unroll
        for (int nb = 0; nb < 2; ++nb) suv[mb][nb] = *(const u32x2*)(praw + (m0 + p) * PROJ_W + OFF_SU + h * 64 + cs + nb * 16 + 4 * fq);
    }
    u32x4 raw[2][4];
#pragma unroll
    for (int hh = 0; hh < 2; ++hh) {
        const int q = hh * 64 + lane;
        const bf16* src = praw + (m0 + q) * PROJ_W + OFF_SV + wave * 32;
        float ss = 0.f;
#pragma unroll
        for (int i = 0; i < 4; ++i) { raw[hh][i] = *(const u32x4*)(src + i * 8);
#pragma unroll
            for (int h = 0; h < 4; ++h) { const float a = bf_lo(raw[hh][i][h]), b = bf_hi(raw[hh][i][h]); ss += a * a + b * b; } }
        psum[wave * 128 + q] = ss;
    }
    __syncthreads();
#pragma unroll
    for (int hh = 0; hh < 2; ++hh) {
        const int q = hh * 64 + lane;
        float tot = 0.f;
#pragma unroll
        for (int w = 0; w < 8; ++w) tot += psum[w * 128 + q];
        const float rs = __builtin_amdgcn_rsqf(tot * (1.0f / 256.0f) + EPS);
#pragma unroll
        for (int i = 0; i < 4; ++i)
#pragma unroll
            for (int h = 0; h < 4; ++h) {
                const int c = wave * 32 + i * 8 + 2 * h;
                const unsigned w2 = pk2(bf_lo(raw[hh][i][h]) * rs * gsg[c], bf_hi(raw[hh][i][h]) * rs * gsg[c + 1]);
                vnT[c * VP + q] = (bf16)(w2 & 0xffffu); vnT[(c + 1) * VP + q] = (bf16)(w2 >> 16);
            }
    }
    __syncthreads();
    f32x4 acc[4][2];
#pragma unroll
    for (int mb = 0; mb < 4; ++mb)
#pragma unroll
        for (int nb = 0; nb < 2; ++nb) acc[mb][nb] = (f32x4){0.f, 0.f, 0.f, 0.f};
#pragma unroll
    for (int kk = 0; kk < 4; ++kk) {
        bf16x8 bfr[2];
#pragma unroll
        for (int nb = 0; nb < 2; ++nb) bfr[nb] = *(const LAS bf16x8*)(vnT + (h * 64 + cs + nb * 16 + fr) * VP + kk * 32 + fq * 8);
#pragma unroll
        for (int mb = 0; mb < 4; ++mb) {
#pragma unroll
            for (int nb = 0; nb < 2; ++nb) acc[mb][nb] = __builtin_amdgcn_mfma_f32_16x16x32_bf16(bfr[nb], afr[mb][kk], acc[mb][nb], 0, 0, 0);
        }
    }
#pragma unroll
    for (int mb = 0; mb < 4; ++mb) {
        const int p = ph * 64 + mb * 16 + fr;
        const float bias = biasv[mb];
        const size_t m = m0 + p;
#pragma unroll
        for (int nb = 0; nb < 2; ++nb) {
            const int c = h * 64 + cs + nb * 16 + 4 * fq;
            const u32x2 su = suv[mb][nb];
            const f32x4 a = acc[mb][nb];
            u32x2 w; w.x = pk2(bf_lo(su.x) * (a[0] + bias), bf_hi(su.x) * (a[1] + bias)); w.y = pk2(bf_lo(su.y) * (a[2] + bias), bf_hi(su.y) * (a[3] + bias));
            *(u32x2*)(mix + m * 1024 + 512 + c) = w;
        }
    }
    __syncthreads();
}
__device__ __forceinline__ void act_fixup(int pm, const float* halo, const float* cw, bf16* act, int tid) {
    for (int idx = tid; idx < 2 * (D_FF / 4); idx += NWAVES * 64) {
        const int which = idx / (D_FF / 4), c = (idx - which * (D_FF / 4)) * 4;
        const int hoff = (c >> 7) * 256 + (c & 127);
        const int row = pm * 256 + (which ? 255 : 0), t = row & (SEQ - 1);
        const f32x4 z = (f32x4){0.f, 0.f, 0.f, 0.f};
        const float* hc = halo + (size_t)(pm * 4 + (which ? 3 : 0)) * D_FF2 + hoff;
        const float* hp = which ? halo + (size_t)(pm * 4 + 2) * D_FF2 + hoff : halo + (size_t)((pm - 1) * 4 + 3) * D_FF2 + hoff;
        const float* hn = which ? halo + (size_t)((pm + 1) * 4 + 0) * D_FF2 + hoff : halo + (size_t)(pm * 4 + 1) * D_FF2 + hoff;
        const bool hasp = t > 0, hasn = t < SEQ - 1;
        const f32x4 gc = *(const f32x4*)hc, vc = *(const f32x4*)(hc + 128);
        const f32x4 gp = hasp ? *(const f32x4*)hp : z, vp = hasp ? *(const f32x4*)(hp + 128) : z;
        const f32x4 gn = hasn ? *(const f32x4*)hn : z, vn = hasn ? *(const f32x4*)(hn + 128) : z;
        const f32x4 wg0 = *(const f32x4*)(cw + c), wg1 = *(const f32x4*)(cw + D_FF2 + c), wg2 = *(const f32x4*)(cw + 2 * D_FF2 + c);
        const f32x4 wv0 = *(const f32x4*)(cw + D_FF + c), wv1 = *(const f32x4*)(cw + D_FF2 + D_FF + c), wv2 = *(const f32x4*)(cw + 2 * D_FF2 + D_FF + c);
        const f32x4 g = wg0 * gp + wg1 * gc + wg2 * gn, v = wv0 * vp + wv1 * vc + wv2 * vn;
        float o[4];
#pragma unroll
        for (int j2 = 0; j2 < 4; ++j2) o[j2] = g[j2] * __builtin_amdgcn_rcpf(1.0f + __builtin_amdgcn_exp2f(-1.4426950408889634f * g[j2])) * v[j2];
        u32x2 w; w.x = pk2(o[0], o[1]); w.y = pk2(o[2], o[3]);
        *(u32x2*)(act + (size_t)row * D_FF + c) = w;
    }
}

#define GAS __attribute__((address_space(1)))
#define RLX_AGENT __ATOMIC_RELAXED, __HIP_MEMORY_SCOPE_AGENT
#define XB_TMO      128
#define XB_XCNT(j)  (256  + 64 * (j))
#define XB_XSUB(j)  (1280 + 64 * (j))
#define XB_XGEN(j)  (2304 + 64 * (j))
#define XB_TOP      3328
#define XB_TOPGEN   3392
#define XCD_BAR_WORDS 3456
#define XB_SPIN_CAP (1u << 18)

__device__ __forceinline__ unsigned xb_ld(unsigned* p)              { return __hip_atomic_load(p, __ATOMIC_RELAXED, __HIP_MEMORY_SCOPE_AGENT); }
__device__ __forceinline__ unsigned xb_add(unsigned* p, unsigned v) { return __hip_atomic_fetch_add(p, v, __ATOMIC_RELAXED, __HIP_MEMORY_SCOPE_AGENT); }
__device__ __forceinline__ unsigned xb_xcc_id() { return (unsigned)__builtin_amdgcn_s_getreg((3 << 11) | 20) & 0xFu; }
#define XB_SPIN(cond, bar) do { unsigned _sp = 0; while (cond) { __builtin_amdgcn_s_sleep(1); \
    if ((++_sp & 255u) == 0u) { if (xb_ld(&(bar)[XB_TMO])) break; if (_sp > XB_SPIN_CAP) { atomicAdd(&(bar)[XB_TMO], 1u); break; } } } } while (0)

struct XcdBarrier {
    unsigned* bar; unsigned x;
    volatile LAS unsigned* st;
};

__device__ __forceinline__ XcdBarrier xcd_barrier_post(unsigned* bar, volatile LAS unsigned* st) {
    XcdBarrier b; b.bar = bar; b.x = xb_xcc_id(); b.st = st;
    if (threadIdx.x == 0) (void)xb_add(&bar[XB_XCNT(b.x)], 1u);
    return b;
}
__device__ __forceinline__ void xcd_barrier_complete(unsigned* bar, unsigned x, unsigned& nloc, unsigned& nx) {
    const unsigned G = gridDim.x * gridDim.y * gridDim.z;
    unsigned sum, cnt, mine, sp = 0u;
    for (;;) {
        sum = 0u; cnt = 0u; mine = 0u;
#pragma unroll
        for (unsigned j = 0; j < 16; ++j) { const unsigned c = xb_ld(&bar[XB_XCNT(j)]); sum += c; cnt += (c > 0u) ? 1u : 0u; mine = (j == x) ? c : mine; }
        if (sum == G) break;
        __builtin_amdgcn_s_sleep(1);
        if ((++sp & 255u) == 0u) { if (xb_ld(&bar[XB_TMO])) break; if (sp > XB_SPIN_CAP) { atomicAdd(&bar[XB_TMO], 1u); break; } }
    }
    nloc = mine > 0u ? mine : 1u; nx = cnt > 0u ? cnt : 1u;
}

__device__ __forceinline__ void xcd_barrier(const XcdBarrier& b) {
    asm volatile("s_waitcnt vmcnt(0)" ::: "memory");
    __syncthreads();
    if (threadIdx.x == 0) {
        unsigned* bar = b.bar;
        __builtin_amdgcn_s_waitcnt(0);
        unsigned nloc = b.st[0], nx = b.st[1];
        if (nloc == 0u) { xcd_barrier_complete(bar, b.x, nloc, nx); b.st[0] = nloc; b.st[1] = nx; }
        const unsigned old = xb_add(&bar[XB_XSUB(b.x)], 1u);
        const unsigned gen = old / nloc;
        if (old + 1u == (gen + 1u) * nloc) {
            __builtin_amdgcn_fence(__ATOMIC_RELEASE, "agent");
            asm volatile("s_waitcnt vmcnt(0)" ::: "memory");
            const unsigned og = xb_add(&bar[XB_TOP], 1u);
            const unsigned tg = og / nx;
            if (og + 1u == (tg + 1u) * nx) xb_add(&bar[XB_TOPGEN], 1u);
            else XB_SPIN(xb_ld(&bar[XB_TOPGEN]) == tg, bar);
            __builtin_amdgcn_fence(__ATOMIC_ACQUIRE, "agent");
            xb_add(&bar[XB_XGEN(b.x)], 1u);
            asm volatile("s_waitcnt vmcnt(0)" ::: "memory");
        } else {
            XB_SPIN(xb_ld(&bar[XB_XGEN(b.x)]) == gen, bar);
            __builtin_amdgcn_fence(__ATOMIC_ACQUIRE, "agent");
            asm volatile("s_waitcnt vmcnt(0)" ::: "memory");
        }
    }
    __syncthreads();
}
constexpr int CW_BAR = 4096;
constexpr size_t CTL_ZERO_BYTES = 65536;
constexpr int MISC_OFF = 131072 + 320;

__device__ __forceinline__ void build_rstd_table(const float* part, const pg8::StaticOrder& S, int tid) {
    LAS float* tbl = (LAS float*)pg8::RSTD_TBL_OFF; pg8::Unit u;
    for (int i = 0; i < 8 && S.next(i, u); ++i)
        if (tid < 256) { const f32x4* pp = (const f32x4*)(part + (size_t)(u.pm * 256 + tid) * 16);
            const f32x4 p0 = pp[0], p1 = pp[1], p2 = pp[2], p3 = pp[3]; const f32x4 ps = (p0 + p1) + (p2 + p3);
            tbl[i * 256 + tid] = __builtin_amdgcn_rsqf(((ps[0] + ps[1]) + (ps[2] + ps[3])) * (1.0f / 1024.0f) + EPS); }
    __syncthreads();
}

struct Args { const float* in[14]; float* out; unsigned char* ws; };
enum { I_X = 0, I_N1G, I_WIN, I_QG, I_KG, I_SGG, I_SGW, I_SGB, I_CONVW, I_WOUT, I_N2G, I_WUP, I_FCW, I_WDOWN };

__global__ void __launch_bounds__(NWAVES * 64, 2) mk_fwd(Args args) {
    extern __shared__ __attribute__((aligned(16))) unsigned char lds_raw[];
    LAS unsigned char* lds = (LAS unsigned char*)lds_raw;
    cg::grid_group grid = cg::this_grid();
    for (int u = threadIdx.x; u < (LDS_BYTES - 131072) / 4; u += NWAVES * 64) ((LAS unsigned*)(lds + 131072))[u] = 0u;
    __syncthreads();
    (void)xcd_barrier_post((unsigned*)args.ws + CW_BAR, (volatile LAS unsigned*)(lds + MISC_OFF) + 8);
    grid.sync();
#ifndef REP_SYNC
#define REP_SYNC 1
#endif
#ifndef REP_P1
#define REP_P1 1
#endif
#ifndef REP_P1B
#define REP_P1B 1
#endif
#ifndef REP_ATT
#define REP_ATT 1
#endif
#ifndef REP_P4
#define REP_P4 1
#endif
#define GSYNC() do { for (int r_ = 0; r_ < REP_SYNC; ++r_) { XcdBarrier bar_; bar_.bar = (unsigned*)args.ws + CW_BAR; bar_.x = xb_xcc_id(); bar_.st = (volatile LAS unsigned*)(lds + MISC_OFF) + 8; xcd_barrier(bar_); } } while (0)
#ifndef PHMASK
#define PHMASK 0xff
#endif
#define PH(k) ((PHMASK >> (k)) & 1)
#define PHASE_VARS() PHASE_VARS_L(l)
#define PHASE_VARS_L(LAYER) int tid = threadIdx.x; asm volatile("" : "+v"(tid)); const int lane = tid & 63, wave = __builtin_amdgcn_readfirstlane(tid >> 6); \
    const int G = gridDim.x, bx = blockIdx.x; const int vcu = (G % 8 == 0) ? (bx % 8) * (G / 8) + bx / 8 : bx; const int NGW = G * NWAVES; const int gw = vcu * NWAVES + wave; (void)NGW; \
    GAS unsigned char* wsg_ = (GAS unsigned char*)args.ws; asm volatile("" : "+s"(wsg_)); unsigned char* ws = (unsigned char*)wsg_;     (void)lane; (void)gw; \
    float* part1 = (float*)(ws + WS_PART1); float* part2 = (float*)(ws + WS_PART2); bf16* sgw_b = (bf16*)(ws + WS_SGW); \
    unsigned char* wset = ws + WS_WSET + (size_t)(LAYER & 1) * WSET_BYTES; unsigned char* wnext = ws + WS_WSET + (size_t)((LAYER + 1) & 1) * WSET_BYTES; (void)wnext; \
    bf16* Win_t = (bf16*)(wset + WO_WIN); bf16* Wout_t = (bf16*)(wset + WO_WOUT); bf16* Wup_t = (bf16*)(wset + WO_WUP); bf16* Wdown_t = (bf16*)(wset + WO_WDOWN); \
    bf16* xb = (bf16*)(ws + WS_XB); float* halo = (float*)(ws + WS_HALO); bf16* praw = (bf16*)(ws + WS_PRAW); \
    bf16* qb = (bf16*)(ws + WS_Q); bf16* kb = (bf16*)(ws + WS_K); bf16* vb = (bf16*)(ws + WS_V); bf16* mix = (bf16*)(ws + WS_MIX); bf16* act = (bf16*)(ws + WS_ACT); \
    const float* x_in = args.in[I_X]; float* xres = args.out; LAS float* scr = (LAS float*)(lds + wave * 16384); \
    (void)part1; (void)part2; (void)sgw_b; (void)Win_t; (void)Wout_t; (void)Wup_t; (void)Wdown_t; (void)xb; (void)halo; (void)praw; (void)qb; (void)kb; (void)vb; (void)mix; (void)act; (void)x_in; (void)xres; (void)scr

    if (PH(0)) {
    PHASE_VARS_L(0);
    for (int m = gw; m < MTOK; m += NGW) {
        const f32x4* xr = (const f32x4*)(x_in + (size_t)m * DMODEL) + lane;
        unsigned long long* o8 = (unsigned long long*)(xb + (size_t)m * DMODEL) + lane;
        float ss = 0.f;
#pragma unroll
        for (int j = 0; j < 4; ++j) { const f32x4 v = xr[64 * j]; ss += (v[0] * v[0] + v[1] * v[1]) + (v[2] * v[2] + v[3] * v[3]);
            o8[64 * j] = (unsigned long long)pk2(v[0], v[1]) | ((unsigned long long)pk2(v[2], v[3]) << 32); }
        ss = wave_sum(ss);
        if (lane < 16) part1[(size_t)m * 16 + lane] = lane == 0 ? ss : 0.f;
    }
    { const float* sgw = args.in[I_SGW]; const int n8 = DEPTH * 4 * 128 * 128 / 8;
      for (int i = bx * 512 + tid; i < n8; i += G * 512) { const f32x4 a = *(const f32x4*)(sgw + (size_t)i * 8), b = *(const f32x4*)(sgw + (size_t)i * 8 + 4);
          u32x4 w; w.x = pk2(a[0], a[1]); w.y = pk2(a[2], a[3]); w.z = pk2(b[0], b[1]); w.w = pk2(b[2], b[3]); *(u32x4*)(sgw_b + (size_t)i * 8) = w; } }
    { const ConvJob j0{args.in[I_WIN], args.in[I_N1G], Win_t, DMODEL, PROJ_W, 2}, j1{args.in[I_WOUT], nullptr, Wout_t, DMODEL, DMODEL, 0},
                    j2{args.in[I_WUP], args.in[I_N2G], Wup_t, DMODEL, D_FF2, 1}, j3{args.in[I_WDOWN], nullptr, Wdown_t, D_FF, DMODEL, 0};
      convert_weights(j0, j1, j2, j3, 4, scr, gw, NGW, lane); }
    }
    GSYNC();

#pragma unroll 1
    for (int l = 0; l < DEPTH; ++l) {
        for (int rp = 0; rp < REP_P1; ++rp) if (PH(1)) { PHASE_VARS();
          pg8::Gemm g{xb, Win_t, MTOK, PROJ_W, DMODEL}; pg8::StaticOrder S; S.init(MTOK, PROJ_W, G, bx);
          pg8::EpiInProj E{praw, PROJ_W, kb, vb, args.in[I_KG] + l * 64}; build_rstd_table(part1, S, tid);
          pg8::gemm_phase<pg8::EpiInProj, pg8::StaticOrder, false, true>(lds, g, S, E, tid); }
        GSYNC();
        for (int rp = 0; rp < REP_ATT; ++rp) if (PH(3)) { PHASE_VARS();
          const attn_body::AttnTensors AT{(const attn_body::bf16*)praw, (const attn_body::bf16*)kb, (const attn_body::bf16*)vb, (attn_body::bf16*)mix, args.in[I_QG] + l * 64};
          const attn_body::StaticOrder S(G, vcu);
          float gqm = fabsf(args.in[I_QG][l * 64 + lane]), gkm = fabsf(args.in[I_KG][l * 64 + lane]);
#pragma unroll
          for (int o = 1; o < 64; o <<= 1) { gqm = fmaxf(gqm, __shfl_xor(gqm, o)); gkm = fmaxf(gkm, __shfl_xor(gkm, o)); }
          const bool fixed_ref = __builtin_amdgcn_readfirstlane((gqm * gkm < 4.0f) ? 1 : 0) != 0;
          if (fixed_ref) attn_body::attn_phase<attn_body::StaticOrder, 8, false>((char*)lds_raw, AT, S, tid);
          else attn_body::attn_phase<attn_body::StaticOrder, 8, true>((char*)lds_raw, AT, S, tid);
          for (int it = vcu; it < 256; it += G)
              sg_item(lds, it, praw, sgw_b + (size_t)l * 4 * 128 * 128, args.in[I_SGB] + l * 4 * 128, args.in[I_SGG] + l * 256, mix, wave, lane);
          p1b_rows(praw, mix, args.in[I_CONVW] + l * 3 * 256, gw, NGW, lane); }
        GSYNC();
        if (PH(4)) { PHASE_VARS();
          pg8::Gemm g{mix, Wout_t, MTOK, DMODEL, DMODEL}; pg8::StaticOrder S; S.init(MTOK, DMODEL, G, bx);
          pg8::EpiResid E{xb, part2, nullptr};
          pg8::gemm_phase<pg8::EpiResid, pg8::StaticOrder, true, true>(lds, g, S, E, tid); }
        GSYNC();
        for (int rp = 0; rp < REP_P4; ++rp) if (PH(5)) { PHASE_VARS();
          pg8::Gemm g{xb, Wup_t, MTOK, D_FF2, DMODEL}; pg8::StaticOrder S; S.init(MTOK, D_FF2, G, bx);
          pg8::EpiConvAct E{act, args.in[I_FCW] + (size_t)l * 3 * D_FF2, (long)WS_HALO - (long)WS_ACT}; build_rstd_table(part2, S, tid);
          pg8::gemm_phase<pg8::EpiConvAct, pg8::StaticOrder, true, true>(lds, g, S, E, tid); }
          if (PH(5) && l + 1 < DEPTH) { PHASE_VARS();
              const int nu = (MTOK / 256) * (D_FF2 / 256), rem = nu % G, first = rem ? rem : 0, nidle = G - first;
              if (bx >= first) { const int ln = l + 1; const int gw2 = (bx - first) * NWAVES + wave, NGW2 = nidle * NWAVES;
                  const ConvJob j0{args.in[I_WIN] + (size_t)ln * DMODEL * PROJ_W, args.in[I_N1G] + ln * DMODEL, (bf16*)(wnext + WO_WIN), DMODEL, PROJ_W, 2},
                                j1{args.in[I_WOUT] + (size_t)ln * DMODEL * DMODEL, nullptr, (bf16*)(wnext + WO_WOUT), DMODEL, DMODEL, 0},
                                j2{args.in[I_WUP] + (size_t)ln * DMODEL * D_FF2, args.in[I_N2G] + ln * DMODEL, (bf16*)(wnext + WO_WUP), DMODEL, D_FF2, 1},
                                j3{args.in[I_WDOWN] + (size_t)ln * D_FF * DMODEL, nullptr, (bf16*)(wnext + WO_WDOWN), D_FF, DMODEL, 0};
                  convert_weights(j0, j1, j2, j3, 4, scr, gw2, NGW2, lane); } }
        GSYNC();
        if (PH(7)) { PHASE_VARS();
          pg8::Gemm g{act, Wdown_t, MTOK, DMODEL, D_FF}; pg8::StaticOrder S; S.init(MTOK, DMODEL, G, bx);
          { pg8::Unit u; for (int i = 0; S.next(i, u); ++i) act_fixup(u.pm, halo, args.in[I_FCW] + (size_t)l * 3 * D_FF2, act, tid); }
          asm volatile("s_waitcnt vmcnt(0)" ::: "memory"); __syncthreads();
          pg8::EpiResid E{xb, part1, l + 1 == DEPTH ? xres : nullptr};
          pg8::gemm_phase<pg8::EpiResid, pg8::StaticOrder, true, true>(lds, g, S, E, tid); }
        if (l + 1 < DEPTH) GSYNC();
    }
}

extern "C" void kernel_launch(void* const* d_in, const int* in_sizes, int n_in, void* d_out, int out_size, void* d_ws, size_t ws_size, hipStream_t stream) {
    static int grid = 0;
    if (grid == 0) {
        if (n_in != 14 || out_size != MTOK * DMODEL || ws_size < WS_END) { fprintf(stderr, "kernel_launch: unexpected shapes / workspace (n_in %d out %d ws %zu, need %zu)\n", n_in, out_size, ws_size, (size_t)WS_END); grid = -1; return; }
        int dev = 0, cus = 0, per_cu = 0;
        hipGetDevice(&dev);
        hipDeviceGetAttribute(&cus, hipDeviceAttributeMultiprocessorCount, dev);
        hipFuncSetAttribute((const void*)mk_fwd, hipFuncAttributeMaxDynamicSharedMemorySize, LDS_BYTES);
        hipOccupancyMaxActiveBlocksPerMultiprocessor(&per_cu, (const void*)mk_fwd, NWAVES * 64, LDS_BYTES);
        if (per_cu < 1) per_cu = 1;
        grid = cus * per_cu;
        if (grid < 176) { fprintf(stderr, "kernel_launch: grid %d too small for the per-phase tables (needs >= 176 workgroups)\n", grid); grid = -1; return; }
        (void)hipGetLastError();
    }
    if (grid < 0) return;
    Args a{};
    for (int i = 0; i < 14; ++i) a.in[i] = (const float*)d_in[i];
    a.out = (float*)d_out; a.ws = (unsigned char*)d_ws;
    if (hipMemsetAsync(d_ws, 0, CTL_ZERO_BYTES, stream) != hipSuccess) { fprintf(stderr, "memset failed\n"); return; }
    void* kargs[] = {&a};
    hipError_t e = hipLaunchCooperativeKernel((const void*)mk_fwd, dim3(grid), dim3(NWAVES * 64), kargs, LDS_BYTES, stream);
    if (e != hipSuccess) fprintf(stderr, "cooperative launch failed: %s (grid %d)\n", hipGetErrorString(e), grid);
}
```

```cpp
#include <hip/hip_runtime.h>
#include <hip/hip_cooperative_groups.h>
#include <hip/hip_bf16.h>
#include <cstdio>
#include <cstdint>
#include <cmath>
namespace cg = cooperative_groups;
namespace pg8 {
#define PG8_LAS __attribute__((address_space(3)))
typedef unsigned short bf16_t;
typedef short bf16x8 __attribute__((ext_vector_type(8)));
typedef float f32x4 __attribute__((ext_vector_type(4)));
typedef unsigned u32x4 __attribute__((ext_vector_type(4)));
typedef unsigned u32x2 __attribute__((ext_vector_type(2)));
constexpr int BM = 256, BK = 64, HALF = 128, HTB = HALF * BK * 2  , STAGE_BYTES = 8 * HTB, NXCD = 8, WGM = 8;

__host__ __device__ __forceinline__ int lds_byte(int r, int c) { const int st = (r >> 4) * 2 + (c >> 5), rr = r & 15, cc = c & 31, ob = rr * 64 + cc * 2; return st * 1024 + (ob ^ (((ob >> 9) & 1) << 5)); }
__host__ __device__ __forceinline__ void stage_rc(int b, int& R, int& C) { const int st = b / 1024, sb = b % 1024, swz = sb ^ (((sb >> 9) & 1) << 5); R = (st >> 1) * 16 + swz / 64; C = (st & 1) * 32 + (swz % 64) / 2; }
__host__ __device__ __forceinline__ int perm32(int rho) { const int n = rho >> 4, i = rho & 15; return 8 * (i >> 2) + 4 * n + (i & 3); }

struct Unit { int pm, pn, slot; };
struct Gemm { const bf16_t* A; const bf16_t* Bt; int M, N, K; };

struct StaticOrder {
    int nM, nN, nwg, G, c;
    __host__ __device__ __forceinline__ void init(int M, int N, int G_, int c_) { nM = M / BM; nN = N / BM; nwg = nM * nN; G = G_; c = c_; }
    __host__ __device__ __forceinline__ bool next(int i, Unit& u) const {
        const long L = (long)i * G + c; if (L >= nwg) return false;
        int wgid = (int)L; { const int q = nwg / NXCD, r = nwg % NXCD, xcd = wgid % NXCD, off = wgid / NXCD; wgid = (xcd < r ? xcd * (q + 1) : r * (q + 1) + (xcd - r) * q) + off; }
        const int nig = WGM * nN, gid = wgid / nig, fm = gid * WGM, gsz = (nM - fm) < WGM ? (nM - fm) : WGM;
        u.pm = fm + ((wgid % nig) % gsz); u.pn = (wgid % nig) / gsz; u.slot = i; return true;
    }
    __device__ __forceinline__ void a_ready(const Unit&) const {}
    __device__ __forceinline__ void done(const Unit&) const {}
};

__device__ __forceinline__ unsigned cvt_pk_bf16(float lo, float hi) { unsigned r; asm volatile("v_cvt_pk_bf16_f32 %0, %1, %2" : "=v"(r) : "v"(lo), "v"(hi)); return r; }
typedef float f32x2 __attribute__((ext_vector_type(2)));
constexpr float RMS_EPS = 1e-6f;
constexpr int RSTD_TBL_OFF = 131072 + 1024 + 8192;
struct EpiScaleBf16 {
    static constexpr bool PERM = true, AFTER_DRAIN = false;
    bf16_t* O; int ldc;
    __device__ __forceinline__ void operator()(f32x4 (&acc)[2][2][4][2], const Unit& u, int wr, int wc, int fr, int fq) const {
        const int row0 = u.pm * BM + wr * 64 + fr, col0 = u.pn * BM + wc * 32 + 8 * fq;
        const PG8_LAS float* rsT = (const PG8_LAS float*)RSTD_TBL_OFF + u.slot * 256 + wr * 64 + fr;
        typedef __attribute__((address_space(1))) u32x4 gu32x4;
#pragma unroll
        for (int ai = 0; ai < 2; ++ai)
#pragma unroll
            for (int m = 0; m < 4; ++m) {
                const int r = row0 + ai * HALF + m * 16;
                const float rs = rsT[ai * HALF + m * 16];
                bf16_t* rowp = O + (size_t)r * ldc + col0;
#pragma unroll
                for (int bj = 0; bj < 2; ++bj) { const f32x4 v0 = acc[ai][bj][m][0] * rs, v1 = acc[ai][bj][m][1] * rs;
                    u32x4 w; w.x = cvt_pk_bf16(v0[0], v0[1]); w.y = cvt_pk_bf16(v0[2], v0[3]); w.z = cvt_pk_bf16(v1[0], v1[1]); w.w = cvt_pk_bf16(v1[2], v1[3]);
                    *(gu32x4*)(rowp + bj * HALF) = w; }
            }
    }
};
__device__ __forceinline__ float lane_xor32(float v) { const unsigned b = __float_as_uint(v); auto rr = __builtin_amdgcn_permlane32_swap(b, b, false, false); return __uint_as_float(rr[0] ^ rr[1] ^ b); }
struct EpiInProj {
    static constexpr bool PERM = true, AFTER_DRAIN = false;
    bf16_t* O; int ldc; bf16_t* kimg; bf16_t* vimg; const float* gk;
    __device__ __forceinline__ void operator()(f32x4 (&acc)[2][2][4][2], const Unit& u, int wr, int wc, int fr, int fq) const {
        const int row0 = u.pm * BM + wr * 64 + fr;
        const PG8_LAS float* rsT = (const PG8_LAS float*)RSTD_TBL_OFF + u.slot * 256 + wr * 64 + fr;
        typedef __attribute__((address_space(1))) u32x4 gu32x4;
        if (u.pn != 2) {
            const int col0 = u.pn * BM + wc * 32 + 8 * fq;
#pragma unroll
            for (int ai = 0; ai < 2; ++ai)
#pragma unroll
                for (int m = 0; m < 4; ++m) {
                    const int r = row0 + ai * HALF + m * 16;
                    const float rs = rsT[ai * HALF + m * 16];
                    bf16_t* rowp = O + (size_t)r * ldc + col0;
#pragma unroll
                    for (int bj = 0; bj < 2; ++bj) { const f32x4 v0 = acc[ai][bj][m][0] * rs, v1 = acc[ai][bj][m][1] * rs;
                        u32x4 w; w.x = cvt_pk_bf16(v0[0], v0[1]); w.y = cvt_pk_bf16(v0[2], v0[3]); w.z = cvt_pk_bf16(v1[0], v1[1]); w.w = cvt_pk_bf16(v1[2], v1[3]);
                        *(gu32x4*)(rowp + bj * HALF) = w; }
                }
            return;
        }
        { int ln = threadIdx.x; asm volatile("" : "+v"(ln)); fr = ln & 15; fq = (ln >> 4) & 3; }
        const int row0k = u.pm * BM + wr * 64 + fr; const PG8_LAS float* rsTk = (const PG8_LAS float*)RSTD_TBL_OFF + u.slot * 256 + wr * 64 + fr;
        const bool isk = wc < 2; const int kvh = wc & 1;
        float inv[8], gg[2][8];
#pragma unroll
        for (int e = 0; e < 8; ++e) { inv[e] = __builtin_amdgcn_exp2f(-(float)(8 * (fq & 1) + e) * (13.287712379549449f / 16.0f)); gg[0][e] = gk[8 * fq + e]; gg[1][e] = gk[32 + 8 * fq + e]; }
        const float sgn = (fq & 2) ? 1.0f : -1.0f;
#pragma unroll
        for (int ai = 0; ai < 2; ++ai) {
            float crow[8], srow[8];
            if (isk) { const float prow = (float)(((row0k + ai * HALF) & 8191) >> 6);
#pragma unroll
                for (int e = 0; e < 8; ++e) { const float ang = prow * inv[e]; crow[e] = __cosf(ang); srow[e] = __sinf(ang); } }
#pragma unroll
            for (int m = 0; m < 4; ++m) {
                const int r = row0k + ai * HALF + m * 16, t = r & 8191, bb = r >> 13, tile = t >> 6, r6 = t & 63;
                const float rs = rsTk[ai * HALF + m * 16];
                float x[2][8]; float ss = 0.f;
#pragma unroll
                for (int bj = 0; bj < 2; ++bj)
#pragma unroll
                    for (int e = 0; e < 8; ++e) { x[bj][e] = acc[ai][bj][m][e >> 2][e & 3] * rs; ss += x[bj][e] * x[bj][e]; }
                const size_t img = ((size_t)(bb * 2 + kvh) * 128 + tile) * 4096;
                if (isk) {
                    ss += __shfl_xor(ss, 16); ss += lane_xor32(ss);
                    const float rk = __builtin_amdgcn_rsqf(ss * (1.0f / 64.0f) + RMS_EPS);
#pragma unroll
                    for (int bj = 0; bj < 2; ++bj) {
                        const float pos = (float)(bj == 0 ? (t >> 6) : (t & 63));
                        float o[8];
#pragma unroll
                        for (int e = 0; e < 8; ++e) {
                            const float xn = x[bj][e] * rk * gg[bj][e];
                            const float other = lane_xor32(xn);
                            float c, sn;
                            if (bj == 0) { c = crow[e]; sn = srow[e]; } else { const float ang = pos * inv[e]; c = __cosf(ang); sn = __sinf(ang); }
                            o[e] = xn * c + sgn * other * sn;
                        }
                        u32x4 w; w.x = cvt_pk_bf16(o[0], o[1]); w.y = cvt_pk_bf16(o[2], o[3]); w.z = cvt_pk_bf16(o[4], o[5]); w.w = cvt_pk_bf16(o[6], o[7]);
                        *(gu32x4*)(kimg + img + (4 * bj + fq) * 512 + r6 * 8) = w;
                    }
                } else {
#pragma unroll
                    for (int bj = 0; bj < 2; ++bj) {
                        u32x4 w; w.x = cvt_pk_bf16(x[bj][0], x[bj][1]); w.y = cvt_pk_bf16(x[bj][2], x[bj][3]); w.z = cvt_pk_bf16(x[bj][4], x[bj][5]); w.w = cvt_pk_bf16(x[bj][6], x[bj][7]);
                        *(gu32x4*)(vimg + img + (bj * 4 + (r6 >> 4)) * 512 + ((r6 & 15) * 4 + fq) * 8) = w;
                    }
                }
                asm volatile("" ::: "memory"); __builtin_amdgcn_sched_barrier(0);
            }
        }
    }
};
struct EpiResid {
    static constexpr bool PERM = true, AFTER_DRAIN = false;
    bf16_t* xb; float* part; float* out;
    __device__ __forceinline__ void operator()(f32x4 (&acc)[2][2][4][2], const Unit& u, int wr, int wc, int fr, int fq) const {
        const int row0 = u.pm * BM + wr * 64 + fr, col0 = u.pn * BM + wc * 32 + 8 * fq;
        typedef __attribute__((address_space(1))) u32x4 gu32x4; typedef __attribute__((address_space(1))) f32x4 gf32x4;
#pragma unroll
        for (int ai = 0; ai < 2; ++ai)
#pragma unroll
            for (int m = 0; m < 4; ++m) {
                const int r = row0 + ai * HALF + m * 16;
                const size_t off = (size_t)r * 1024 + col0;
                float ss = 0.f;
#pragma unroll
                for (int bj = 0; bj < 2; ++bj) {
                    const u32x4 raw = *(const gu32x4*)(xb + off + bj * HALF);
                    const f32x4 a = (f32x4){__uint_as_float(raw.x << 16), __uint_as_float(raw.x & 0xffff0000u), __uint_as_float(raw.y << 16), __uint_as_float(raw.y & 0xffff0000u)};
                    const f32x4 b = (f32x4){__uint_as_float(raw.z << 16), __uint_as_float(raw.z & 0xffff0000u), __uint_as_float(raw.w << 16), __uint_as_float(raw.w & 0xffff0000u)};
                    const f32x4 v0 = a + acc[ai][bj][m][0], v1 = b + acc[ai][bj][m][1];
                    if (out) { *(gf32x4*)(out + off + bj * HALF) = v0; *(gf32x4*)(out + off + bj * HALF + 4) = v1; }
                    else {
                        u32x4 w; w.x = cvt_pk_bf16(v0[0], v0[1]); w.y = cvt_pk_bf16(v0[2], v0[3]); w.z = cvt_pk_bf16(v1[0], v1[1]); w.w = cvt_pk_bf16(v1[2], v1[3]);
                        *(gu32x4*)(xb + off + bj * HALF) = w;
                        ss += (v0[0] * v0[0] + v0[1] * v0[1]) + (v0[2] * v0[2] + v0[3] * v0[3]) + (v1[0] * v1[0] + v1[1] * v1[1]) + (v1[2] * v1[2] + v1[3] * v1[3]);
                    }
                }
                if (!out) { ss += __shfl_xor(ss, 16); ss += __shfl_xor(ss, 32);
                    if (fq == 0) part[(size_t)r * 16 + u.pn * 4 + wc] = ss; }
                if (m & 1) asm volatile("" ::: "memory");
            }
    }
};
__device__ __forceinline__ float dpp_ror1(float v) { return __builtin_bit_cast(float, __builtin_amdgcn_mov_dpp(__builtin_bit_cast(int, v), 0x121, 0xf, 0xf, true)); }
__device__ __forceinline__ float dpp_rol1(float v) { return __builtin_bit_cast(float, __builtin_amdgcn_mov_dpp(__builtin_bit_cast(int, v), 0x12f, 0xf, 0xf, true)); }
struct EpiConvAct {
    static constexpr bool PERM = true, AFTER_DRAIN = false;
    bf16_t* act; const float* cw; long halo_off;
    __device__ __forceinline__ void operator()(f32x4 (&acc)[2][2][4][2], const Unit& u, int wr, int wc, int fr, int fq) const {
        float* halo = (float*)((char*)act + halo_off); PG8_LAS float* ex = (PG8_LAS float*)(131072 + 1024);
        const int row0 = u.pm * BM + wr * 64 + fr, cl = wc * 32 + 8 * fq;
        typedef __attribute__((address_space(1))) const f32x4 gf32x4;
        const PG8_LAS float* rsT = (const PG8_LAS float*)RSTD_TBL_OFF + u.slot * 256;
#pragma unroll
        for (int ai = 0; ai < 2; ++ai)
#pragma unroll
            for (int m = 0; m < 4; ++m) {
                const float rs = rsT[wr * 64 + fr + ai * HALF + m * 16];
#pragma unroll
                for (int bj = 0; bj < 2; ++bj)
#pragma unroll
                    for (int n = 0; n < 2; ++n) acc[ai][bj][m][n] *= rs;
            }
#pragma unroll
        for (int ai = 0; ai < 2; ++ai) {
            const int gidx = ai * 2 + wr;
            if (fr == 0) {
#pragma unroll
                for (int bj = 0; bj < 2; ++bj)
#pragma unroll
                    for (int n = 0; n < 2; ++n) *(PG8_LAS f32x4*)(ex + (gidx * 2 + 0) * 256 + bj * HALF + cl + 4 * n) = acc[ai][bj][0][n];
            }
            if (fr == 15) {
#pragma unroll
                for (int bj = 0; bj < 2; ++bj)
#pragma unroll
                    for (int n = 0; n < 2; ++n) *(PG8_LAS f32x4*)(ex + (gidx * 2 + 1) * 256 + bj * HALF + cl + 4 * n) = acc[ai][bj][3][n];
            }
        }
        if (wr == 0 && fr < 2) {
#pragma unroll
            for (int bj = 0; bj < 2; ++bj)
#pragma unroll
                for (int n = 0; n < 2; ++n) *(__attribute__((address_space(1))) f32x4*)(halo + (size_t)(u.pm * 4 + fr) * 5632 + u.pn * BM + bj * HALF + cl + 4 * n) = acc[0][bj][0][n];
        }
        if (wr == 1 && fr >= 14) {
#pragma unroll
            for (int bj = 0; bj < 2; ++bj)
#pragma unroll
                for (int n = 0; n < 2; ++n) *(__attribute__((address_space(1))) f32x4*)(halo + (size_t)(u.pm * 4 + 2 + (fr - 14)) * 5632 + u.pn * BM + bj * HALF + cl + 4 * n) = acc[1][bj][3][n];
        }
        asm volatile("s_waitcnt lgkmcnt(0)" ::: "memory"); __builtin_amdgcn_s_barrier(); asm volatile("" ::: "memory");
        const int ccol = u.pn * HALF + cl;
        u32x2 res0[2][4];
#pragma unroll
        for (int n = 0; n < 2; ++n) {
            f32x4 wgt[3][2];
#pragma unroll
            for (int k = 0; k < 3; ++k) { wgt[k][0] = *(gf32x4*)(cw + k * 5632 + ccol + 4 * n); wgt[k][1] = *(gf32x4*)(cw + k * 5632 + 2816 + ccol + 4 * n); }
#pragma unroll
            for (int ai = 0; ai < 2; ++ai) {
                const int gidx = ai * 2 + wr;
                f32x4 top[2], bot[2];
#pragma unroll
                for (int bj = 0; bj < 2; ++bj) {
                    top[bj] = gidx > 0 ? *(const PG8_LAS f32x4*)(ex + ((gidx - 1) * 2 + 1) * 256 + bj * HALF + cl + 4 * n) : (f32x4){0.f, 0.f, 0.f, 0.f};
                    bot[bj] = gidx < 3 ? *(const PG8_LAS f32x4*)(ex + ((gidx + 1) * 2 + 0) * 256 + bj * HALF + cl + 4 * n) : (f32x4){0.f, 0.f, 0.f, 0.f};
                }
#pragma unroll
                for (int m = 0; m < 4; ++m) {
                    f32x2 y[2][2];
#pragma unroll
                    for (int bj = 0; bj < 2; ++bj) {
                        const f32x4 cur = acc[ai][bj][m][n];
#pragma unroll
                        for (int p = 0; p < 2; ++p) {
                            f32x2 prev2, next2, cur2 = (f32x2){cur[2 * p], cur[2 * p + 1]};
#pragma unroll
                            for (int q = 0; q < 2; ++q) { const int j = 2 * p + q;
                                const float pin = dpp_ror1(cur[j]);
                                const float pedge = (m > 0) ? dpp_ror1(acc[ai][bj][m > 0 ? m - 1 : 0][n][j]) : top[bj][j];
                                const float nin = dpp_rol1(cur[j]);
                                const float nedge = (m < 3) ? dpp_rol1(acc[ai][bj][m < 3 ? m + 1 : 3][n][j]) : bot[bj][j];
                                prev2[q] = fr == 0 ? pedge : pin; next2[q] = fr == 15 ? nedge : nin; }
                            const f32x2 w0 = (f32x2){wgt[0][bj][2 * p], wgt[0][bj][2 * p + 1]}, w1 = (f32x2){wgt[1][bj][2 * p], wgt[1][bj][2 * p + 1]}, w2 = (f32x2){wgt[2][bj][2 * p], wgt[2][bj][2 * p + 1]};
                            y[bj][p] = w0 * prev2 + w1 * cur2 + w2 * next2;
                        }
                    }
                    float o[4];
#pragma unroll
                    for (int p = 0; p < 2; ++p) {
                        const f32x2 g = y[0][p], t = g * -1.4426950408889634f;
                        f32x2 e; e[0] = __builtin_amdgcn_exp2f(t[0]); e[1] = __builtin_amdgcn_exp2f(t[1]);
                        const f32x2 d = e + 1.0f;
                        f32x2 r; r[0] = __builtin_amdgcn_rcpf(d[0]); r[1] = __builtin_amdgcn_rcpf(d[1]);
                        const f32x2 o2 = (g * r) * y[1][p];
                        o[2 * p] = o2[0]; o[2 * p + 1] = o2[1];
                    }
                    const int r = row0 + ai * HALF + m * 16;
                    u32x2 w; w.x = cvt_pk_bf16(o[0], o[1]); w.y = cvt_pk_bf16(o[2], o[3]);
                    if (n == 0) res0[ai][m] = w;
                    else { u32x4 w4; w4.x = res0[ai][m].x; w4.y = res0[ai][m].y; w4.z = w.x; w4.w = w.y; *(__attribute__((address_space(1))) u32x4*)(act + (size_t)r * 2816 + ccol) = w4; }
                    asm volatile("" ::: "memory"); __builtin_amdgcn_sched_barrier(0);
                }
            }
        }
    }
};

template <class Epi, class Sched, bool ALIGN_EPI = false, bool SP2 = false>
__device__ __forceinline__ void gemm_phase(PG8_LAS unsigned char* lds, const Gemm g, const Sched& S, const Epi& E, const int tid) {
    const int wid = __builtin_amdgcn_readfirstlane(tid >> 6), lane = tid & 63, wr = wid >> 2, wc = wid & 3, fr = lane & 15, fq = lane >> 4;
    const int K = g.K, nt = K / BK;
    unsigned voffA[2], voffB[2];
#pragma unroll
    for (int i = 0; i < 2; ++i) { int R, C; stage_rc(tid * 16 + i * 8192, R, C); const int Rb = Epi::PERM ? ((R & ~31) + perm32(R & 31)) : R;
        voffA[i] = (unsigned)(R * K + C) * 2u; voffB[i] = (unsigned)(Rb * K + C) * 2u; }
    const size_t kstep = (size_t)(BK * 2);
    const size_t hstep = (size_t)HALF * K * 2;
    const size_t tstep = 2 * hstep;
    const unsigned ldsw = (unsigned)wid * 1024u;
    const int aoff = lds_byte(wr * 64 + fr, fq * 8), boff = lds_byte(wc * 32 + fr, fq * 8);
#define PG8_SA(b, h) (((b) * 2 + (h)) * HTB)
#define PG8_SB(b, h) ((4 + (b) * 2 + (h)) * HTB)
#define PG8_STAGE(bufoff, gbase, voff) do { _Pragma("unroll") for (int _i = 0; _i < 2; ++_i) \
        __builtin_amdgcn_global_load_lds((const unsigned*)((const char*)(gbase) + (voff)[_i]), (PG8_LAS unsigned*)(lds + (bufoff) + ldsw + _i * 8192), 16, 0, 0); } while (0)
#define PG8_LDA(dst, b, h) do { _Pragma("unroll") for (int m = 0; m < 4; ++m) _Pragma("unroll") for (int k = 0; k < 2; ++k) dst[m][k] = *(const PG8_LAS bf16x8*)(lds + PG8_SA(b, h) + aoff + m * 2048 + k * 1024); } while (0)
#define PG8_LDB(dst, b, h) do { _Pragma("unroll") for (int n = 0; n < 2; ++n) _Pragma("unroll") for (int k = 0; k < 2; ++k) dst[n][k] = *(const PG8_LAS bf16x8*)(lds + PG8_SB(b, h) + boff + n * 2048 + k * 1024); } while (0)
#define PG8_MMA(ai, bj, At, Bt) do { __builtin_amdgcn_s_setprio(1); _Pragma("unroll") for (int m = 0; m < 4; ++m) _Pragma("unroll") for (int n = 0; n < 2; ++n) _Pragma("unroll") for (int k = 0; k < 2; ++k) \
        acc[ai][bj][m][n] = __builtin_amdgcn_mfma_f32_16x16x32_bf16(Bt[n][k], At[m][k], acc[ai][bj][m][n], 0, 0, 0); __builtin_amdgcn_s_setprio(0); } while (0)
#define PG8_WAIT_V(n) asm volatile("s_waitcnt vmcnt(" #n ")" ::: "memory")
#define PG8_WAIT_L(n) asm volatile("s_waitcnt lgkmcnt(" #n ")" ::: "memory")
#define PG8_BAR __builtin_amdgcn_s_barrier()
#define PG8_SCHED __builtin_amdgcn_sched_barrier(0)
    Unit cur, nxt; int ui = 0;
    if (!S.next(0, cur)) return;
    f32x4 acc[2][2][4][2];
#pragma unroll
    for (int a = 0; a < 2; ++a)
#pragma unroll
        for (int b = 0; b < 2; ++b)
#pragma unroll
            for (int m = 0; m < 4; ++m)
#pragma unroll
                for (int n = 0; n < 2; ++n) acc[a][b][m][n] = (f32x4){0.f, 0.f, 0.f, 0.f};
    bf16x8 At[4][2], B0[2][2], B1[2][2];
    const char* cA = (const char*)g.A + (size_t)cur.pm * tstep; const char* cB = (const char*)g.Bt + (size_t)cur.pn * tstep;
    S.a_ready(cur);
    if constexpr (SP2) {
        PG8_STAGE(PG8_SB(0, 0), cB, voffB); PG8_STAGE(PG8_SB(0, 1), cB + hstep, voffB); PG8_STAGE(PG8_SA(0, 0), cA, voffA); PG8_STAGE(PG8_SA(0, 1), cA + hstep, voffA);
        if (wr == 1) PG8_BAR;
        PG8_WAIT_V(2); PG8_BAR;
        PG8_STAGE(PG8_SB(1, 0), cB + kstep, voffB); PG8_STAGE(PG8_SA(1, 0), cA + kstep, voffA); PG8_STAGE(PG8_SB(1, 1), cB + hstep + kstep, voffB);
        PG8_WAIT_V(6); PG8_BAR;
    } else {
        PG8_STAGE(PG8_SB(0, 0), cB, voffB); PG8_STAGE(PG8_SA(0, 0), cA, voffA); PG8_STAGE(PG8_SB(0, 1), cB + hstep, voffB); PG8_STAGE(PG8_SA(0, 1), cA + hstep, voffA);
        if (wr == 1) PG8_BAR;
        PG8_WAIT_V(4); PG8_BAR;
        PG8_STAGE(PG8_SB(1, 0), cB + kstep, voffB); PG8_STAGE(PG8_SA(1, 0), cA + kstep, voffA); PG8_STAGE(PG8_SB(1, 1), cB + hstep + kstep, voffB);
        PG8_WAIT_V(6); PG8_BAR;
    }
    for (;;) {
        const bool has_next = S.next(ui + 1, nxt);
        const char* nA = has_next ? (const char*)g.A + (size_t)nxt.pm * tstep : cA; const char* nB = has_next ? (const char*)g.Bt + (size_t)nxt.pn * tstep : cB;
        for (int t = 0; t < nt; t += 2) {
            const bool last = (t == nt - 2);
            const char* a1 = cA + (size_t)(t + 1) * kstep;
            const char* a2 = last ? nA : cA + (size_t)(t + 2) * kstep; const char* b2 = last ? nB : cB + (size_t)(t + 2) * kstep;
            const char* a3 = a2 + kstep; const char* b3 = b2 + kstep;
            if (last && has_next) S.a_ready(nxt);
            if constexpr (SP2) {
            PG8_LDB(B0, 0, 0); PG8_LDB(B1, 0, 1); PG8_SCHED; PG8_LDA(At, 0, 0); PG8_STAGE(PG8_SA(1, 1), a1 + hstep, voffA);
            PG8_WAIT_V(8); PG8_WAIT_L(0); PG8_BAR; PG8_MMA(0, 0, At, B0); PG8_MMA(0, 1, At, B1); PG8_BAR; PG8_SCHED;
            PG8_LDA(At, 0, 1); PG8_STAGE(PG8_SB(0, 0), b2, voffB); PG8_STAGE(PG8_SB(0, 1), b2 + hstep, voffB); PG8_STAGE(PG8_SA(0, 0), a2, voffA);
            PG8_WAIT_V(8); PG8_WAIT_L(0); PG8_BAR; PG8_MMA(1, 0, At, B0); PG8_MMA(1, 1, At, B1); PG8_BAR; PG8_SCHED;
            PG8_LDB(B0, 1, 0); PG8_LDB(B1, 1, 1); PG8_SCHED; PG8_LDA(At, 1, 0); PG8_STAGE(PG8_SA(0, 1), a2 + hstep, voffA);
            PG8_WAIT_V(8); PG8_WAIT_L(0); PG8_BAR; PG8_MMA(0, 0, At, B0); PG8_MMA(0, 1, At, B1); PG8_BAR; PG8_SCHED;
            PG8_LDA(At, 1, 1); PG8_STAGE(PG8_SB(1, 0), b3, voffB); PG8_STAGE(PG8_SB(1, 1), b3 + hstep, voffB); PG8_STAGE(PG8_SA(1, 0), a3, voffA);
            PG8_WAIT_V(8); PG8_WAIT_L(0); PG8_BAR; PG8_MMA(1, 0, At, B0); PG8_MMA(1, 1, At, B1); PG8_BAR; PG8_SCHED;
            } else {
            PG8_LDB(B0, 0, 0); PG8_SCHED; PG8_LDA(At, 0, 0); PG8_STAGE(PG8_SA(1, 1), a1 + hstep, voffA);
            PG8_WAIT_L(8); PG8_BAR; PG8_WAIT_L(0); PG8_MMA(0, 0, At, B0); PG8_BAR; PG8_SCHED;
            PG8_LDB(B1, 0, 1); PG8_STAGE(PG8_SB(0, 0), b2, voffB);
            PG8_BAR; PG8_WAIT_L(0); PG8_MMA(0, 1, At, B1); PG8_BAR;
            PG8_LDA(At, 0, 1); PG8_STAGE(PG8_SA(0, 0), a2, voffA);
            PG8_BAR; PG8_WAIT_L(0); PG8_MMA(1, 0, At, B0); PG8_BAR; PG8_SCHED;
            PG8_STAGE(PG8_SB(0, 1), b2 + hstep, voffB);
            PG8_WAIT_V(6); PG8_BAR; PG8_MMA(1, 1, At, B1); PG8_BAR;
            PG8_LDB(B0, 1, 0); PG8_SCHED; PG8_LDA(At, 1, 0); PG8_STAGE(PG8_SA(0, 1), a2 + hstep, voffA);
            PG8_WAIT_L(8); PG8_BAR; PG8_WAIT_L(0); PG8_MMA(0, 0, At, B0); PG8_BAR; PG8_SCHED;
            PG8_LDB(B1, 1, 1); PG8_STAGE(PG8_SB(1, 0), b3, voffB);
            PG8_BAR; PG8_WAIT_L(0); PG8_MMA(0, 1, At, B1); PG8_BAR;
            PG8_LDA(At, 1, 1); PG8_STAGE(PG8_SA(1, 0), a3, voffA);
            PG8_BAR; PG8_WAIT_L(0); PG8_MMA(1, 0, At, B0); PG8_BAR; PG8_SCHED;
            PG8_STAGE(PG8_SB(1, 1), b3 + hstep, voffB);
            PG8_WAIT_V(6); PG8_BAR; PG8_MMA(1, 1, At, B1); PG8_BAR;
            }
        }
        if constexpr (ALIGN_EPI) { if (wr == 0) PG8_BAR; }
        if constexpr (!Epi::AFTER_DRAIN) { E(acc, cur, wr, wc, fr, fq); S.done(cur); }
        if (!has_next) break;
#pragma unroll
        for (int a = 0; a < 2; ++a)
#pragma unroll
            for (int b = 0; b < 2; ++b)
#pragma unroll
                for (int m = 0; m < 4; ++m)
#pragma unroll
                    for (int n = 0; n < 2; ++n) acc[a][b][m][n] = (f32x4){0.f, 0.f, 0.f, 0.f};
        cur = nxt; cA = nA; cB = nB; ++ui;
        if constexpr (ALIGN_EPI) { if (wr == 1) PG8_BAR; }
    }
    PG8_WAIT_V(0);
    if constexpr (!ALIGN_EPI) { if (wr == 0) PG8_BAR; }
    PG8_BAR;
    if constexpr (Epi::AFTER_DRAIN) { E.fused(acc, cur, wr, wc, fr, fq, lds, wid, lane); S.done(cur); }
#undef PG8_SA
#undef PG8_SB
#undef PG8_STAGE
#undef PG8_LDA
#undef PG8_LDB
#undef PG8_MMA
#undef PG8_WAIT_V
#undef PG8_WAIT_L
#undef PG8_BAR
#undef PG8_SCHED
}
}
namespace attn_body {
using bf16=__hip_bfloat16;
using bf16x8=__attribute__((ext_vector_type(8)))short;
using s16x4=__attribute__((ext_vector_type(4)))short;
using f32x16=__attribute__((ext_vector_type(16)))float;
using u32x4=__attribute__((ext_vector_type(4)))unsigned;
constexpr int BATCH=2,NHEAD=8,SEQ=8192,D=64,QP=2048,KP=128,VP=128,OP=1024;
constexpr int NW=8,QBLK=32,QB=QBLK*NW,KVBLK=64,NQB=SEQ/QB;
constexpr int ATTN_UNIT_ROWS=QB;
__device__ __forceinline__ int crow(int r,int hi){return (r&3)+8*(r>>2)+4*hi;}
#define SBAR() __builtin_amdgcn_sched_barrier(0)
__device__ __forceinline__ void cmask(f32x16&p0,f32x16&p1,int jb,int qrel,int hi){
  const float NEG=-INFINITY; int kb=64*jb+4*hi;
  #pragma unroll
  for(int r=0;r<16;++r){int kv=kb+(r&3)+8*(r>>2); if(kv>qrel)p0[r]=NEG; if(kv+32>qrel)p1[r]=NEG;}
}

constexpr int NSLOT=3, SLOTB=8192;
constexpr int LDS_K=0, LDS_V=NSLOT*SLOTB, LDS_WS=2*NSLOT*SLOTB, LDS_OST=LDS_WS+NW*64*4, LDS_BYTES=LDS_OST+NW*4096;
constexpr float C2=0.125f*1.4426950408889634f;
__device__ __forceinline__ void glds16(const void*gsrc,unsigned lds_dst){unsigned keep;
  asm volatile("s_mov_b32 %0, m0\n\ts_mov_b32 m0, %2\n\ts_nop 0\n\tglobal_load_lds_dwordx4 %1, off\n\ts_mov_b32 m0, %0":"=&s"(keep):"v"(gsrc),"s"(lds_dst):"memory");}
__device__ __forceinline__ float max3f(float a,float b,float c){float r;asm("v_max3_f32 %0, %1, %2, %3":"=v"(r):"v"(a),"v"(b),"v"(c));return r;}
__device__ __forceinline__ float max2f(float a,float b){float r;asm("v_max_f32_e32 %0, %1, %2":"=v"(r):"v"(a),"v"(b));return r;}
__device__ __forceinline__ float fadd_s(float a,float b){float r;asm("v_add_f32_e32 %0, %1, %2":"=v"(r):"v"(a),"v"(b));return r;}
__device__ __forceinline__ float fsub_s(float a,float b){float r;asm("v_sub_f32_e32 %0, %1, %2":"=v"(r):"v"(a),"v"(b));return r;}
typedef float f32x2_t __attribute__((ext_vector_type(2))); typedef __bf16 bf16x2_t __attribute__((ext_vector_type(2)));
__device__ __forceinline__ unsigned cvtpk_s(float lo,float hi){f32x2_t v={lo,hi};bf16x2_t b=__builtin_convertvector(v,bf16x2_t);return __builtin_bit_cast(unsigned,b);}
#define WAIT_BAR(N) asm volatile("s_waitcnt vmcnt(" #N ") lgkmcnt(0)\n\ts_barrier":::"memory")

__device__ __forceinline__ void qkt(f32x16&p0,f32x16&p1,const char*Kslot,const bf16x8*qr,const f32x16&negm,int r32,int hi){
  const char*kb=Kslot+hi*1024+r32*16;
  #pragma unroll
  for(int d0=0;d0<4;++d0){
    const bf16x8 b0=*reinterpret_cast<const bf16x8*>(kb+d0*2048);
    const bf16x8 b1=*reinterpret_cast<const bf16x8*>(kb+d0*2048+512);
    if(d0==0){p0=__builtin_amdgcn_mfma_f32_32x32x16_bf16(b0,qr[0],negm,0,0,0);p1=__builtin_amdgcn_mfma_f32_32x32x16_bf16(b1,qr[0],negm,0,0,0);}
    else{p0=__builtin_amdgcn_mfma_f32_32x32x16_bf16(b0,qr[d0],p0,0,0,0);p1=__builtin_amdgcn_mfma_f32_32x32x16_bf16(b1,qr[d0],p1,0,0,0);}}
}
typedef __attribute__((address_space(3))) const char* lds_cptr;
typedef short v4i16_t __attribute__((ext_vector_type(4)));
__device__ __forceinline__ void kload8(bf16x8*kf,lds_cptr kp){
  kf[0]=*(const __attribute__((address_space(3))) bf16x8*)(kp);      kf[1]=*(const __attribute__((address_space(3))) bf16x8*)(kp+512);
  kf[2]=*(const __attribute__((address_space(3))) bf16x8*)(kp+2048); kf[3]=*(const __attribute__((address_space(3))) bf16x8*)(kp+2560);
  kf[4]=*(const __attribute__((address_space(3))) bf16x8*)(kp+4096); kf[5]=*(const __attribute__((address_space(3))) bf16x8*)(kp+4608);
  kf[6]=*(const __attribute__((address_space(3))) bf16x8*)(kp+6144); kf[7]=*(const __attribute__((address_space(3))) bf16x8*)(kp+6656);
}
__device__ __forceinline__ void kload2(bf16x8*kf,lds_cptr kp,int j){ kf[2*j]=*(const __attribute__((address_space(3))) bf16x8*)(kp+j*2048); kf[2*j+1]=*(const __attribute__((address_space(3))) bf16x8*)(kp+j*2048+512); }
__device__ __forceinline__ s16x4 vtr(lds_cptr p){ return __builtin_bit_cast(s16x4,__builtin_amdgcn_ds_read_tr16_b64_v4i16((__attribute__((address_space(3))) v4i16_t*)p)); }
__device__ __forceinline__ float rowmax(const f32x16&p0,const f32x16&p1){
  float a=max3f(p0[0],p0[1],p1[0]),b=max3f(p0[2],p0[3],p1[1]);a=max3f(a,p1[2],p1[3]);
  #pragma unroll
  for(int r=4;r<16;r+=4){a=max3f(a,p0[r],p0[r+1]);b=max3f(b,p0[r+2],p0[r+3]);a=max3f(a,p1[r],p1[r+1]);b=max3f(b,p1[r+2],p1[r+3]);}
  const float m=max2f(a,b);
  auto rr=__builtin_amdgcn_permlane32_swap(__float_as_uint(m),__float_as_uint(m),false,false);
  return max2f(__uint_as_float(rr[0]),__uint_as_float(rr[1]));
}
__device__ __forceinline__ void pv(f32x16*o,int vb,bf16x8 pa0,bf16x8 pa1,bf16x8 pa2,bf16x8 pa3){
  #pragma unroll
  for(int d0=0;d0<2;++d0){s16x4 lo[4],hi[4];
    #pragma unroll
    for(int ks=0;ks<4;++ks){
      asm volatile("ds_read_b64_tr_b16 %0,%1 offset:%c2":"=&v"(lo[ks]):"v"(vb),"i"(d0*4096+ks*1024):"memory");
      asm volatile("ds_read_b64_tr_b16 %0,%1 offset:%c2":"=&v"(hi[ks]):"v"(vb),"i"(d0*4096+ks*1024+512):"memory");}
    asm volatile("s_waitcnt lgkmcnt(0)":::"memory");SBAR();
    #define PK(k) (bf16x8){lo[k][0],lo[k][1],lo[k][2],lo[k][3],hi[k][0],hi[k][1],hi[k][2],hi[k][3]}
    o[d0]=__builtin_amdgcn_mfma_f32_32x32x16_bf16(pa0,PK(0),o[d0],0,0,0);
    o[d0]=__builtin_amdgcn_mfma_f32_32x32x16_bf16(pa1,PK(1),o[d0],0,0,0);
    o[d0]=__builtin_amdgcn_mfma_f32_32x32x16_bf16(pa2,PK(2),o[d0],0,0,0);
    o[d0]=__builtin_amdgcn_mfma_f32_32x32x16_bf16(pa3,PK(3),o[d0],0,0,0);
    #undef PK
  }
}

#ifndef ATTN_STORE16
#define ATTN_STORE16(p,v) (*(u32x4*)(p)=(v))
#endif
template<int THRL,bool TRACK> __device__ __forceinline__ void attn_unit(int b,int h,int kvh,int qb,const bf16*Q,const bf16*__restrict__ K,const bf16*__restrict__ V,bf16*O,const float*gq,char*shm,const int tid){
  const int lane=tid&63,r32=lane&31,hi=lane>>5; const int wid=__builtin_amdgcn_readfirstlane(tid>>6);
  const long rowbase=(long)b*SEQ; const int q0=qb*QB;
  const bf16*Qw=Q+(rowbase+q0+wid*QBLK)*QP+h*D;
  const bf16*Kh=K+(long)(b*2+kvh)*(SEQ/KVBLK)*4096,*Vh=V+(long)(b*2+kvh)*(SEQ/KVBLK)*4096;
  const unsigned lds0=(unsigned)(uintptr_t)shm;
  float*wsf=(float*)(shm+LDS_WS)+wid*64;
  const bf16*ksrc=Kh+wid*512+lane*8;
  const bf16*vsrc=Vh+wid*512+lane*8;
  const unsigned kdst=lds0+LDS_K+wid*1024, vdst=lds0+LDS_V+wid*1024;
  #define DMA_K(t,slot) glds16(ksrc+(long)(t)*4096,(unsigned)__builtin_amdgcn_readfirstlane(kdst+(slot)))
  #define DMA_V(t,slot) glds16(vsrc+(long)(t)*4096,(unsigned)__builtin_amdgcn_readfirstlane(vdst+(slot)))
  const int vb0=(int)(lds0+LDS_V)+((lane>>4)&1)*32+(lane&3)*8+(4*hi+((lane&15)>>2))*64;
  const char*Kbase=shm+LDS_K; bf16x8 kf[8];
  const lds_cptr shm3=(lds_cptr)shm; const lds_cptr kp0=shm3+LDS_K+hi*1024+r32*16; const lds_cptr vp0=shm3+LDS_V+((lane>>4)&1)*32+(lane&3)*8+(4*hi+((lane&15)>>2))*64;
  const int NT=SEQ/KVBLK;
  DMA_K(0,0);DMA_V(0,0);DMA_K(1,SLOTB);
  bf16x8 qr[4];
  { u32x4 raw[4];
    #pragma unroll
    for(int d0=0;d0<4;++d0)raw[d0]=*reinterpret_cast<const u32x4*>(&Qw[(long)r32*QP+d0*16+hi*8]);
    float ss=0.f;
    #pragma unroll
    for(int d0=0;d0<4;++d0){
      #pragma unroll
      for(int w=0;w<4;++w){ const float lo=__uint_as_float(raw[d0][w]<<16), hh=__uint_as_float(raw[d0][w]&0xffff0000u); ss+=lo*lo+hh*hh; } }
    { auto rr=__builtin_amdgcn_permlane32_swap(__float_as_uint(ss),__float_as_uint(ss),false,false); ss=__uint_as_float(rr[0])+__uint_as_float(rr[1]); }
    const float rs=__builtin_amdgcn_rsqf(ss*(1.0f/64.0f)+1e-6f)*C2;
    const int tq=q0+wid*QBLK+r32;
    #pragma unroll
    for(int part=0;part<2;++part){
      const float pos=(float)(part==0?(tq>>6):(tq&63));
      float y0[8],y1[8];
      #pragma unroll
      for(int e=0;e<8;++e){
        const float inv=__builtin_amdgcn_exp2f(-(float)(8*hi+e)*(13.287712379549449f/16.0f));
        const float ang=pos*inv; const float c=__cosf(ang), sn=__sinf(ang);
        const unsigned w0=raw[2*part][e>>1], w1=raw[2*part+1][e>>1];
        const float a0=((e&1)?__uint_as_float(w0&0xffff0000u):__uint_as_float(w0<<16))*rs*gq[32*part+8*hi+e];
        const float a1=((e&1)?__uint_as_float(w1&0xffff0000u):__uint_as_float(w1<<16))*rs*gq[32*part+16+8*hi+e];
        y0[e]=a0*c-a1*sn; y1[e]=a0*sn+a1*c; }
      u32x4 wa,wb;
      #pragma unroll
      for(int w=0;w<4;++w){ wa[w]=cvtpk_s(y0[2*w],y0[2*w+1]); wb[w]=cvtpk_s(y1[2*w],y1[2*w+1]); }
      qr[2*part]=__builtin_bit_cast(bf16x8,wa); qr[2*part+1]=__builtin_bit_cast(bf16x8,wb);
      asm volatile("":"+v"(qr[2*part]),"+v"(qr[2*part+1])); SBAR(); } }
  float mhat=0.f,l_reg=0.f;f32x16 o[2],negm; { float zf=0.f; asm volatile("":"+v"(zf));
    _Pragma("unroll") for(int r=0;r<16;++r){o[0][r]=zf;o[1][r]=zf;negm[r]=zf;} } asm volatile("":"+v"(negm));

  #define CMASK(P0,P1,t) do{}while(0)
  bool resc=false;
  #define START(P0,P1) do{ const float rm=rowmax(P0,P1); resc=false; \
    { const float dl=rm; mhat=fadd_s(mhat,dl); \
      _Pragma("unroll") for(int r=0;r<16;++r){P0[r]=fsub_s(P0[r],dl);P1[r]=fsub_s(P1[r],dl);} \
      _Pragma("unroll") for(int r=0;r<16;++r)negm[r]=-mhat; asm volatile("":"+v"(negm)); } \
    _Pragma("unroll") for(int r=0;r<16;++r)P0[r]=__builtin_amdgcn_exp2f(P0[r]); }while(0)
  #define RESC() do{ if(resc){ asm volatile("s_waitcnt lgkmcnt(0)":::"memory"); \
      _Pragma("unroll") for(int d_=0;d_<2;++d_) _Pragma("unroll") for(int r=0;r<16;++r)o[d_][r]*=wsf[crow(r,hi)]; } }while(0)
  f32x16 pA0,pA1,pB0,pB1;
  int sl_prev=0,sl_cur=0,sl_next=SLOTB;
  #define ROT() do{sl_prev=sl_cur;sl_cur=sl_next;sl_next=(sl_next==(NSLOT-1)*SLOTB)?0:sl_next+SLOTB;}while(0)
  DMA_K(2,2*SLOTB);
  WAIT_BAR(3);
  qkt(pA0,pA1,Kbase,qr,negm,r32,hi);asm volatile("s_nop 15\n\ts_nop 7":"+v"(pA0),"+v"(pA1));CMASK(pA0,pA1,0);
  START(pA0,pA1);
  _Pragma("unroll") for(int r=0;r<16;++r)pA1[r]=__builtin_amdgcn_exp2f(pA1[r]);
  WAIT_BAR(0);
  DMA_K(3,0);DMA_V(1,SLOTB);
  ROT();
  kload8(kf,kp0+sl_cur);
  WAIT_BAR(2);
  s16x4 vlo[8],vhi[8]; u32x4 pw0,pw1,pw2,pw3;
  #define PKW(P,B) cvtpk_s(P[B],P[B+1])
  #define PAF(k) __builtin_bit_cast(bf16x8,pw##k)
  #define VFR(i) (bf16x8){vlo[i][0],vlo[i][1],vlo[i][2],vlo[i][3],vhi[i][0],vhi[i][1],vhi[i][2],vhi[i][3]}
  #define PIN(x) asm volatile("":"+v"(x))
  #define MX3(a,b,c) __builtin_fmaxf(__builtin_fmaxf((a),(b)),(c))
  #define GAPA(MF,A0,A1,A2,A3,W0,W1,PW) do{ MF; sacc+=A0; sacc+=A1; sacc+=A2; sacc+=A3; PIN(sacc); W0; W1; PIN(PW); SBAR(); }while(0)
  #define EX(v) __builtin_amdgcn_exp2f(v)
  #define GAPB(MF,X,B) do{ MF; X[B]=EX(X[B]); X[B+1]=EX(X[B+1]); X[B+2]=EX(X[B+2]); X[B+3]=EX(X[B+3]); PIN(X); SBAR(); }while(0)
  #define VRD(i) do{ vlo[i]=vtr(vp_+(((i)>>2)*4096+((i)&3)*1024)); vhi[i]=vtr(vp_+(((i)>>2)*4096+((i)&3)*1024+512)); }while(0)
  #define KRD(G,j) do{ if(G){ kload2(kf,kp0+sl_next,j); SBAR(); } }while(0)
  #define STEP(C0,C1,P0,P1,t,GK,GV,GL) do{ SBAR(); \
    const lds_cptr vp_=vp0+sl_prev; \
    VRD(0); SBAR(); float sacc=(P0[0]+P0[1]); \
    GAPA(C0=__builtin_amdgcn_mfma_f32_32x32x16_bf16(kf[0],qr[0],negm,0,0,0), P0[2],P0[3],P0[4],P0[5],     pw0[0]=PKW(P0,0), pw0[1]=PKW(P0,2), pw0); \
    VRD(4); SBAR(); GAPA(C1=__builtin_amdgcn_mfma_f32_32x32x16_bf16(kf[1],qr[0],negm,0,0,0), P0[6],P0[7],P0[8],P0[9],     pw0[2]=PKW(P0,4), pw0[3]=PKW(P0,6), pw0); \
    VRD(1); SBAR(); GAPA(C0=__builtin_amdgcn_mfma_f32_32x32x16_bf16(kf[2],qr[1],C0,0,0,0),   P0[10],P0[11],P0[12],P0[13], pw1[0]=PKW(P0,8), pw1[1]=PKW(P0,10), pw1); \
    VRD(5); SBAR(); GAPA(C1=__builtin_amdgcn_mfma_f32_32x32x16_bf16(kf[3],qr[1],C1,0,0,0),   P0[14],P0[15],P1[0],P1[1],   pw1[2]=PKW(P0,12),pw1[3]=PKW(P0,14), pw1); \
    VRD(2); SBAR(); GAPA(C0=__builtin_amdgcn_mfma_f32_32x32x16_bf16(kf[4],qr[2],C0,0,0,0),   P1[2],P1[3],P1[4],P1[5],     pw2[0]=PKW(P1,0), pw2[1]=PKW(P1,2), pw2); \
    VRD(6); SBAR(); GAPA(C1=__builtin_amdgcn_mfma_f32_32x32x16_bf16(kf[5],qr[2],C1,0,0,0),   P1[6],P1[7],P1[8],P1[9],     pw2[2]=PKW(P1,4), pw2[3]=PKW(P1,6), pw2); \
    VRD(3); SBAR(); GAPA(C0=__builtin_amdgcn_mfma_f32_32x32x16_bf16(kf[6],qr[3],C0,0,0,0),   P1[10],P1[11],P1[12],P1[13], pw3[0]=PKW(P1,8), pw3[1]=PKW(P1,10), pw3); \
    VRD(7); SBAR(); GAPA(C1=__builtin_amdgcn_mfma_f32_32x32x16_bf16(kf[7],qr[3],C1,0,0,0),   P1[14],P1[15],0.f,0.f,       pw3[2]=PKW(P1,12),pw3[3]=PKW(P1,14), pw3); \
    l_reg+=sacc; \
    if(GK){DMA_K((t)+3,sl_cur);} if(GV){DMA_V((t)+1,sl_next);} \
    CMASK(C0,C1,t); \
    if(TRACK){ float a=MX3(C0[0],C0[1],C1[0]),b=MX3(C0[2],C0[3],C1[1]); a=MX3(a,C1[2],C1[3]); \
      _Pragma("unroll") for(int r=4;r<16;r+=4){a=MX3(a,C0[r],C0[r+1]);b=MX3(b,C0[r+2],C0[r+3]);a=MX3(a,C1[r],C1[r+1]);b=MX3(b,C1[r+2],C1[r+3]);} \
      float rm=__builtin_fmaxf(a,b); { auto rr=__builtin_amdgcn_permlane32_swap(__float_as_uint(rm),__float_as_uint(rm),false,false); rm=__builtin_fmaxf(__uint_as_float(rr[0]),__uint_as_float(rr[1])); } \
      resc=false; \
      if(__builtin_expect(__any(rm>(float)THRL),0)){ const float dl=__builtin_fmaxf(rm,0.f); mhat+=dl; \
        _Pragma("unroll") for(int r=0;r<16;++r){C0[r]-=dl;C1[r]-=dl;} \
        _Pragma("unroll") for(int r=0;r<16;++r)negm[r]=-mhat; asm volatile("":"+v"(negm)); \
        const float f=__builtin_amdgcn_exp2f(-dl); l_reg*=f; if(hi==0)wsf[r32]=f; resc=true; } } \
    SBAR(); \
    GAPB(o[0]=__builtin_amdgcn_mfma_f32_32x32x16_bf16(PAF(0),VFR(0),o[0],0,0,0), C0,0); \
    GAPB(o[1]=__builtin_amdgcn_mfma_f32_32x32x16_bf16(PAF(0),VFR(4),o[1],0,0,0), C0,4); \
    KRD(GL,0); GAPB(o[0]=__builtin_amdgcn_mfma_f32_32x32x16_bf16(PAF(1),VFR(1),o[0],0,0,0), C0,8); \
    KRD(GL,1); GAPB(o[1]=__builtin_amdgcn_mfma_f32_32x32x16_bf16(PAF(1),VFR(5),o[1],0,0,0), C0,12); \
    KRD(GL,2); GAPB(o[0]=__builtin_amdgcn_mfma_f32_32x32x16_bf16(PAF(2),VFR(2),o[0],0,0,0), C1,0); \
    KRD(GL,3); GAPB(o[1]=__builtin_amdgcn_mfma_f32_32x32x16_bf16(PAF(2),VFR(6),o[1],0,0,0), C1,4); \
    GAPB(o[0]=__builtin_amdgcn_mfma_f32_32x32x16_bf16(PAF(3),VFR(3),o[0],0,0,0), C1,8); \
    GAPB(o[1]=__builtin_amdgcn_mfma_f32_32x32x16_bf16(PAF(3),VFR(7),o[1],0,0,0), C1,12); \
    }while(0)
  int t=1;
  #undef CMASK
  #define CMASK(P0,P1,t) do{}while(0)
  for(;t+5<NT;t+=2){
    STEP(pB0,pB1,pA0,pA1,t,true,true,true);     WAIT_BAR(2); RESC(); ROT();
    STEP(pA0,pA1,pB0,pB1,t+1,true,true,true);   WAIT_BAR(2); RESC(); ROT();
  }
  #undef CMASK
  #define CMASK(P0,P1,t) do{}while(0)
  #define ENDW(tt) do{ if((tt)+3<NT){WAIT_BAR(2);} else if((tt)+2<NT){WAIT_BAR(1);} else {WAIT_BAR(0);} }while(0)
  for(;t+1<NT;t+=2){
    STEP(pB0,pB1,pA0,pA1,t,(t+3<NT),(t+1<NT),(t+1<NT));       ENDW(t);   RESC(); ROT();
    STEP(pA0,pA1,pB0,pB1,t+1,(t+4<NT),(t+2<NT),(t+2<NT));     ENDW(t+1); RESC(); ROT();
  }
  STEP(pB0,pB1,pA0,pA1,NT-1,false,false,false); RESC();
  { float sacc=pB0[0]+pB0[1]; _Pragma("unroll") for(int r=2;r<16;++r)sacc+=pB0[r]; _Pragma("unroll") for(int r=0;r<16;++r)sacc+=pB1[r]; l_reg+=sacc;
    pw0=(u32x4){PKW(pB0,0),PKW(pB0,2),PKW(pB0,4),PKW(pB0,6)};pw1=(u32x4){PKW(pB0,8),PKW(pB0,10),PKW(pB0,12),PKW(pB0,14)};pw2=(u32x4){PKW(pB1,0),PKW(pB1,2),PKW(pB1,4),PKW(pB1,6)};pw3=(u32x4){PKW(pB1,8),PKW(pB1,10),PKW(pB1,12),PKW(pB1,14)};
    SBAR(); pv(o,vb0+sl_cur,PAF(0),PAF(1),PAF(2),PAF(3)); }
  #undef PKW
  #undef PAF
  #undef VFR
  #undef PIN
  #undef MX3
  #undef GAPA
  #undef GAPB
  #undef EX
  #undef VRD
  #undef KRD
  #undef STEP
  #undef ENDW
  {auto rr=__builtin_amdgcn_permlane32_swap(__float_as_uint(l_reg),__float_as_uint(l_reg),false,false);l_reg=__uint_as_float(rr[0])+__uint_as_float(rr[1]);}
  if(hi==0)wsf[32+r32]=l_reg;asm volatile("s_waitcnt lgkmcnt(0)":::"memory");
  float rli[16];
  #pragma unroll
  for(int r=0;r<16;++r)rli[r]=__builtin_amdgcn_rcpf(wsf[32+crow(r,hi)]);
  bf16*Ow=O+(rowbase+q0+wid*QBLK)*OP+h*D;
  { bf16*stg=(bf16*)(shm+LDS_OST)+wid*2048;
    #pragma unroll
    for(int r=0;r<16;++r){const int orow=crow(r,hi);
      #pragma unroll
      for(int d0=0;d0<2;++d0)stg[orow*64+d0*32+r32]=__float2bfloat16(o[d0][r]*rli[r]);}
    asm volatile("s_waitcnt lgkmcnt(0)":::"memory");
    #pragma unroll
    for(int i=0;i<4;++i){const int row=i*8+(lane>>3),ch=lane&7; const u32x4 v=*(const u32x4*)(stg+row*64+ch*8); ATTN_STORE16(Ow+(long)row*OP+ch*8,v);} }
  asm volatile("s_waitcnt lgkmcnt(0)\n\ts_barrier":::"memory");
  #undef DMA_K
  #undef DMA_V
  #undef CMASK
  #undef START
  #undef RESC
  #undef ROT
}
constexpr int ATTN_LDS_BYTES=LDS_BYTES;
struct AttnTensors { const bf16* Q; const bf16* K; const bf16* V; bf16* O; const float* gq; };
struct AttnUnit { int b, h, kvh, qb; };
struct StaticOrder {
  int vcu, G;
  __device__ __forceinline__ StaticOrder(int grid,int vcu_):vcu(vcu_),G(grid){}
  __device__ __forceinline__ bool next(int i,AttnUnit&u)const{ const int U=i*G+vcu; if(U>=512)return false; const int grp=(U>>6)&3, idx=(U&63)|((U>>8)<<6);
    u.b=grp>>1; u.kvh=grp&1; u.h=(grp&1)*4+(idx>>5); u.qb=idx&31; return true; }
};
template<class Sched,int THRL,bool TRACK> __device__ __forceinline__ void attn_phase(char*lds,const AttnTensors&T,const Sched&S,const int tid){
  AttnUnit u;
  for(int i=0;S.next(i,u);++i){ attn_unit<THRL,TRACK>(u.b,u.h,u.kvh,u.qb,T.Q,T.K,T.V,T.O,T.gq,lds,tid); }
}
#undef SBAR
#undef WAIT_BAR
}
constexpr int NWAVES = 8;
constexpr int BATCH = 2, SEQ = 8192, DMODEL = 1024, MTOK = BATCH * SEQ, DEPTH = 4;
constexpr int PROJ_W = 2048, D_FF = 2816, D_FF2 = 5632;
constexpr int OFF_Q = 0, OFF_K = 512, OFF_V = 640, OFF_SU = 768, OFF_SV = 1024, OFF_CB = 1280, OFF_CC = 1536, OFF_CX = 1792;
constexpr float EPS = 1e-6f;
constexpr float QSCALE = 0.125f * 1.4426950408889634f;
constexpr size_t MiB = 1u << 20;
constexpr size_t WS_PART1 = 1 * MiB, WS_PART2 = 2 * MiB, WS_SGW = 3 * MiB;
constexpr size_t WS_WSET = 4 * MiB, WSET_BYTES = 23 * MiB;
constexpr size_t WO_WIN = 0, WO_WOUT = 4 * MiB, WO_WUP = 6 * MiB, WO_WDOWN = 17 * MiB;
constexpr size_t WS_XB = 50 * MiB;
constexpr size_t WS_PRAW = 82 * MiB, WS_Q = 146 * MiB, WS_K = 162 * MiB, WS_V = 166 * MiB;
constexpr size_t WS_ACT = 82 * MiB;
constexpr size_t WS_MIX = 170 * MiB;
constexpr size_t WS_HALO = 202 * MiB;
constexpr size_t WS_END = 208 * MiB;
constexpr int LDS_BYTES = 153600;

#define LAS __attribute__((address_space(3)))
typedef unsigned short bf16;
typedef unsigned u32x4 __attribute__((ext_vector_type(4)));
typedef unsigned u32x2 __attribute__((ext_vector_type(2)));
typedef float f32x4 __attribute__((ext_vector_type(4)));
typedef short bf16x8 __attribute__((ext_vector_type(8)));

__device__ __forceinline__ unsigned pk2(float lo, float hi) { return pg8::cvt_pk_bf16(lo, hi); }
__device__ __forceinline__ float bf_lo(unsigned u) { return __uint_as_float(u << 16); }
__device__ __forceinline__ float bf_hi(unsigned u) { return __uint_as_float(u & 0xffff0000u); }
__device__ __forceinline__ float wave_sum(float v) {
#pragma unroll
    for (int o = 1; o < 64; o <<= 1) v += __shfl_xor(v, o);
    return v;
}
__device__ __forceinline__ int perm_up(int c) { const int v = c >= D_FF ? 1 : 0, cc = c - v * D_FF; return ((cc >> 7) << 8) + v * 128 + (cc & 127); }
__device__ __forceinline__ int perm_in(int c) { if (c < 512 || c >= 768) return c; const int oc = c - 512, hl = oc >> 6, d = oc & 63; return 512 + (d >> 5) * 128 + hl * 32 + (d & 31); }
__device__ __forceinline__ void transpose_item(const float* W, int K, int N, bf16* WT, const float* g, LAS float* scr, int item, int lane, int permup) {
    const int nblk = N / 32, kb = item / nblk, nb = item % nblk, k0 = 64 * kb, n0 = 32 * nb;
    float wv[32];
#pragma unroll
    for (int i = 0; i < 32; ++i) wv[i] = W[(size_t)(k0 + 2 * i + (lane >> 5)) * N + n0 + (lane & 31)];
#pragma unroll
    for (int i = 0; i < 32; ++i) { const int kk = 2 * i + (lane >> 5); float w = wv[i]; if (g) w *= g[k0 + kk]; scr[kk * 33 + (lane & 31)] = w; }
    asm volatile("s_waitcnt lgkmcnt(0)" ::: "memory");
    const int c = lane & 7;
#pragma unroll
    for (int j = 0; j < 4; ++j) { const int n = (lane >> 3) + 8 * j; const LAS float* s = scr + (8 * c) * 33 + n;
        u32x4 o; o.x = pk2(s[0 * 33], s[1 * 33]); o.y = pk2(s[2 * 33], s[3 * 33]); o.z = pk2(s[4 * 33], s[5 * 33]); o.w = pk2(s[6 * 33], s[7 * 33]);
        const int nrow = permup == 1 ? perm_up(n0 + n) : permup == 2 ? perm_in(n0 + n) : n0 + n;
        *(u32x4*)(WT + (size_t)nrow * K + k0 + 8 * c) = o; }
    asm volatile("s_waitcnt lgkmcnt(0)" ::: "memory");
}
struct ConvJob { const float* W; const float* g; bf16* WT; int K, N; int permup; };
__device__ __forceinline__ void convert_weights(const ConvJob& j0, const ConvJob& j1, const ConvJob& j2, const ConvJob& j3, int njobs, LAS float* scr, int gw, int NGW, int lane) {
    const int n0 = (j0.K / 64) * (j0.N / 32), n1 = njobs > 1 ? (j1.K / 64) * (j1.N / 32) : 0, n2 = njobs > 2 ? (j2.K / 64) * (j2.N / 32) : 0, n3 = njobs > 3 ? (j3.K / 64) * (j3.N / 32) : 0;
    const int total = n0 + n1 + n2 + n3;
    for (int it = gw; it < total; it += NGW) {
        if (it < n0) transpose_item(j0.W, j0.K, j0.N, j0.WT, j0.g, scr, it, lane, j0.permup);
        else if (it < n0 + n1) transpose_item(j1.W, j1.K, j1.N, j1.WT, j1.g, scr, it - n0, lane, j1.permup);
        else if (it < n0 + n1 + n2) transpose_item(j2.W, j2.K, j2.N, j2.WT, j2.g, scr, it - n0 - n1, lane, j2.permup);
        else transpose_item(j3.W, j3.K, j3.N, j3.WT, j3.g, scr, it - n0 - n1 - n2, lane, j3.permup);
    }
}
__device__ __forceinline__ u32x4 norm_rope8(u32x4 raw, const float* g, int s8, int t, float scale) {
    float x[8] = {bf_lo(raw.x), bf_hi(raw.x), bf_lo(raw.y), bf_hi(raw.y), bf_lo(raw.z), bf_hi(raw.z), bf_lo(raw.w), bf_hi(raw.w)};
    float ss = 0.f;
#pragma unroll
    for (int e = 0; e < 8; ++e) ss += x[e] * x[e];
    ss += __shfl_xor(ss, 1); ss += __shfl_xor(ss, 2); ss += __shfl_xor(ss, 4);
    const float rs = __builtin_amdgcn_rsqf(ss * (1.0f / 64.0f) + EPS);
    const f32x4 g0 = *(const f32x4*)(g + s8 * 8), g1 = *(const f32x4*)(g + s8 * 8 + 4);
    const float gg[8] = {g0[0], g0[1], g0[2], g0[3], g1[0], g1[1], g1[2], g1[3]};
    const float pos = (float)((s8 < 4) ? (t >> 6) : (t & 63));
    const float sgn = (s8 & 2) ? 1.0f : -1.0f;
    const int j0 = (s8 & 1) * 8;
    float o[8];
#pragma unroll
    for (int e = 0; e < 8; ++e) {
        const float xn = x[e] * rs * gg[e];
        const float other = __shfl_xor(xn, 2);
        const float inv = __builtin_amdgcn_exp2f(-(float)(j0 + e) * (13.287712379549449f / 16.0f));
        const float ang = pos * inv;
        const float c = __cosf(ang), sn = __sinf(ang);
        o[e] = (xn * c + sgn * other * sn) * scale;
    }
    u32x4 w; w.x = pk2(o[0], o[1]); w.y = pk2(o[2], o[3]); w.z = pk2(o[4], o[5]); w.w = pk2(o[6], o[7]); return w;
}
struct RowRaw { u32x4 cb, cc0, cc1, cc2, cx0, cx1, cx2; };
__device__ __forceinline__ RowRaw p1b_load(const bf16* praw, int m, int lane) {
    RowRaw R; const int t = m & (SEQ - 1), c = (lane & 31) * 8; const u32x4 z = (u32x4){0u, 0u, 0u, 0u};
    const bf16* pr = praw + (size_t)m * PROJ_W;
    R.cb = *(const u32x4*)(pr + OFF_CB + c); R.cc1 = *(const u32x4*)(pr + OFF_CC + c); R.cx1 = *(const u32x4*)(pr + OFF_CX + c);
    R.cc0 = t > 0 ? *(const u32x4*)(pr - PROJ_W + OFF_CC + c) : z; R.cx0 = t > 0 ? *(const u32x4*)(pr - PROJ_W + OFF_CX + c) : z;
    R.cc2 = t < SEQ - 1 ? *(const u32x4*)(pr + PROJ_W + OFF_CC + c) : z; R.cx2 = t < SEQ - 1 ? *(const u32x4*)(pr + PROJ_W + OFF_CX + c) : z;
    return R;
}
__device__ __forceinline__ void p1b_proc(const RowRaw& R, int m, bool valid, bf16* mix, const f32x4 (&wt)[3][2], int lane) {
    const int c = (lane & 31) * 8;
    float o[8];
#pragma unroll
    for (int h = 0; h < 4; ++h) {
        const float p0l = bf_lo(R.cc0[h]) * bf_lo(R.cx0[h]), p0h = bf_hi(R.cc0[h]) * bf_hi(R.cx0[h]);
        const float p1l = bf_lo(R.cc1[h]) * bf_lo(R.cx1[h]), p1h = bf_hi(R.cc1[h]) * bf_hi(R.cx1[h]);
        const float p2l = bf_lo(R.cc2[h]) * bf_lo(R.cx2[h]), p2h = bf_hi(R.cc2[h]) * bf_hi(R.cx2[h]);
        const int e0 = 2 * h, e1 = 2 * h + 1;
        o[e0] = bf_lo(R.cb[h]) * (wt[0][e0 >> 2][e0 & 3] * p0l + wt[1][e0 >> 2][e0 & 3] * p1l + wt[2][e0 >> 2][e0 & 3] * p2l);
        o[e1] = bf_hi(R.cb[h]) * (wt[0][e1 >> 2][e1 & 3] * p0h + wt[1][e1 >> 2][e1 & 3] * p1h + wt[2][e1 >> 2][e1 & 3] * p2h);
    }
    u32x4 w; w.x = pk2(o[0], o[1]); w.y = pk2(o[2], o[3]); w.z = pk2(o[4], o[5]); w.w = pk2(o[6], o[7]);
    if (valid) *(u32x4*)(mix + (size_t)m * 1024 + 768 + c) = w;
}
__device__ __forceinline__ void p1b_rows(const bf16* praw, bf16* mix, const float* convw, int gw, int NGW, int lane) {
    const int half = lane >> 5, c = (lane & 31) * 8;
    f32x4 wt[3][2];
#pragma unroll
    for (int k = 0; k < 3; ++k) { wt[k][0] = *(const f32x4*)(convw + k * 256 + c); wt[k][1] = *(const f32x4*)(convw + k * 256 + c + 4); }
    for (int k0 = 0; gw + k0 * NGW < MTOK; k0 += 8) {
        RowRaw R[4]; int mm[4]; bool ok[4];
#pragma unroll
        for (int i = 0; i < 4; ++i) { mm[i] = gw + (k0 + 2 * i + half) * NGW; ok[i] = mm[i] < MTOK; R[i] = p1b_load(praw, ok[i] ? mm[i] : gw, lane); }
#pragma unroll
        for (int i = 0; i < 4; ++i) p1b_proc(R[i], mm[i], ok[i], mix, wt, lane);
    }
}
__device__ __forceinline__ void sg_item(LAS unsigned char* lds, int item, const bf16* praw, const bf16* sgw, const float* sgb, const float* gsg, bf16* mix, int wave, int lane) {
    const int n = item >> 1, ph = item & 1;
    const size_t m0 = (size_t)n * 128;
    LAS float* psum = (LAS float*)lds;
    LAS bf16* vnT = (LAS bf16*)(lds + 4096);
    constexpr int VP = 136;
    const int fr = lane & 15, fq = lane >> 4, h = wave >> 1, cs = (wave & 1) * 32;
    bf16x8 afr[4][4]; u32x2 suv[4][2]; float biasv[4];
#pragma unroll
    for (int mb = 0; mb < 4; ++mb) {
#pragma unroll
        for (int kk = 0; kk < 4; ++kk) afr[mb][kk] = *(const bf16x8*)(sgw + ((size_t)(h * 128 + ph * 64 + mb * 16 + fr) * 128 + kk * 32 + fq * 8));
        const int p = ph * 64 + mb * 16 + fr; biasv[mb] = sgb[h * 128 + p];
#pragma unroll
        for (int nb = 0; nb < 2; ++nb) suv[mb][nb] = *(const u32x2*)(praw + (m0 + p) * PROJ_W + OFF_SU + h * 64 + cs + nb * 16 + 4 * fq);
    }
    u32x4 raw[2][4];
#pragma unroll
    for (int hh = 0; hh < 2; ++hh) {
        const int q = hh * 64 + lane;
        const bf16* src = praw + (m0 + q) * PROJ_W + OFF_SV + wave * 32;
        float ss = 0.f;
#pragma unroll
        for (int i = 0; i < 4; ++i) { raw[hh][i] = *(const u32x4*)(src + i * 8);
#pragma unroll
            for (int h = 0; h < 4; ++h) { const float a = bf_lo(raw[hh][i][h]), b = bf_hi(raw[hh][i][h]); ss += a * a + b * b; } }
        psum[wave * 128 + q] = ss;
    }
    __syncthreads();
#pragma unroll
    for (int hh = 0; hh < 2; ++hh) {
        const int q = hh * 64 + lane;
        float tot = 0.f;
#pragma unroll
        for (int w = 0; w < 8; ++w) tot += psum[w * 128 + q];
        const float rs = __builtin_amdgcn_rsqf(tot * (1.0f / 256.0f) + EPS);
#pragma unroll
        for (int i = 0; i < 4; ++i)
#pragma unroll
            for (int h = 0; h < 4; ++h) {
                const int c = wave * 32 + i * 8 + 2 * h;
                const unsigned w2 = pk2(bf_lo(raw[hh][i][h]) * rs * gsg[c], bf_hi(raw[hh][i][h]) * rs * gsg[c + 1]);
                vnT[c * VP + q] = (bf16)(w2 & 0xffffu); vnT[(c + 1) * VP + q] = (bf16)(w2 >> 16);
            }
    }
    __syncthreads();
    f32x4 acc[4][2];
#pragma unroll
    for (int mb = 0; mb < 4; ++mb)
#pragma unroll
        for (int nb = 0; nb < 2; ++nb) acc[mb][nb] = (f32x4){0.f, 0.f, 0.f, 0.f};
#pragma unroll
    for (int kk = 0; kk < 4; ++kk) {
        bf16x8 bfr[2];
#pragma unroll
        for (int nb = 0; nb < 2; ++nb) bfr[nb] = *(const LAS bf16x8*)(vnT + (h * 64 + cs + nb * 16 + fr) * VP + kk * 32 + fq * 8);
#pragma unroll
        for (int mb = 0; mb < 4; ++mb) {
#pragma unroll
            for (int nb = 0; nb < 2; ++nb) acc[mb][nb] = __builtin_amdgcn_mfma_f32_16x16x32_bf16(bfr[nb], afr[mb][kk], acc[mb][nb], 0, 0, 0);
        }
    }
#pragma unroll
    for (int mb = 0; mb < 4; ++mb) {
        const int p = ph * 64 + mb * 16 + fr;
        const float bias = biasv[mb];
        const size_t m = m0 + p;
#pragma unroll
        for (int nb = 0; nb < 2; ++nb) {
            const int c = h * 64 + cs + nb * 16 + 4 * fq;
            const u32x2 su = suv[mb][nb];
            const f32x4 a = acc[mb][nb];
            u32x2 w; w.x = pk2(bf_lo(su.x) * (a[0] + bias), bf_hi(su.x) * (a[1] + bias)); w.y = pk2(bf_lo(su.y) * (a[2] + bias), bf_hi(su.y) * (a[3] + bias));
            *(u32x2*)(mix + m * 1024 + 512 + c) = w;
        }
    }
    __syncthreads();
}
__device__ __forceinline__ void act_fixup(int pm, const float* halo, const float* cw, bf16* act, int tid) {
    for (int idx = tid; idx < 2 * (D_FF / 4); idx += NWAVES * 64) {
        const int which = idx / (D_FF / 4), c = (idx - which * (D_FF / 4)) * 4;
        const int hoff = (c >> 7) * 256 + (c & 127);
        const int row = pm * 256 + (which ? 255 : 0), t = row & (SEQ - 1);
        const f32x4 z = (f32x4){0.f, 0.f, 0.f, 0.f};
        const float* hc = halo + (size_t)(pm * 4 + (which ? 3 : 0)) * D_FF2 + hoff;
        const float* hp = which ? halo + (size_t)(pm * 4 + 2) * D_FF2 + hoff : halo + (size_t)((pm - 1) * 4 + 3) * D_FF2 + hoff;
        const float* hn = which ? halo + (size_t)((pm + 1) * 4 + 0) * D_FF2 + hoff : halo + (size_t)(pm * 4 + 1) * D_FF2 + hoff;
        const bool hasp = t > 0, hasn = t < SEQ - 1;
        const f32x4 gc = *(const f32x4*)hc, vc = *(const f32x4*)(hc + 128);
        const f32x4 gp = hasp ? *(const f32x4*)hp : z, vp = hasp ? *(const f32x4*)(hp + 128) : z;
        const f32x4 gn = hasn ? *(const f32x4*)hn : z, vn = hasn ? *(const f32x4*)(hn + 128) : z;
        const f32x4 wg0 = *(const f32x4*)(cw + c), wg1 = *(const f32x4*)(cw + D_FF2 + c), wg2 = *(const f32x4*)(cw + 2 * D_FF2 + c);
        const f32x4 wv0 = *(const f32x4*)(cw + D_FF + c), wv1 = *(const f32x4*)(cw + D_FF2 + D_FF + c), wv2 = *(const f32x4*)(cw + 2 * D_FF2 + D_FF + c);
        const f32x4 g = wg0 * gp + wg1 * gc + wg2 * gn, v = wv0 * vp + wv1 * vc + wv2 * vn;
        float o[4];
#pragma unroll
        for (int j2 = 0; j2 < 4; ++j2) o[j2] = g[j2] * __builtin_amdgcn_rcpf(1.0f + __builtin_amdgcn_exp2f(-1.4426950408889634f * g[j2])) * v[j2];
        u32x2 w; w.x = pk2(o[0], o[1]); w.y = pk2(o[2], o[3]);
        *(u32x2*)(act + (size_t)row * D_FF + c) = w;
    }
}

#define GAS __attribute__((address_space(1)))
#define RLX_AGENT __ATOMIC_RELAXED, __HIP_MEMORY_SCOPE_AGENT
#define XB_TMO      128
#define XB_XCNT(j)  (256  + 64 * (j))
#define XB_XSUB(j)  (1280 + 64 * (j))
#define XB_XGEN(j)  (2304 + 64 * (j))
#define XB_TOP      3328
#define XB_TOPGEN   3392
#define XCD_BAR_WORDS 3456
#define XB_SPIN_CAP (1u << 18)

__device__ __forceinline__ unsigned xb_ld(unsigned* p)              { return __hip_atomic_load(p, __ATOMIC_RELAXED, __HIP_MEMORY_SCOPE_AGENT); }
__device__ __forceinline__ unsigned xb_add(unsigned* p, unsigned v) { return __hip_atomic_fetch_add(p, v, __ATOMIC_RELAXED, __HIP_MEMORY_SCOPE_AGENT); }
__device__ __forceinline__ unsigned xb_xcc_id() { return (unsigned)__builtin_amdgcn_s_getreg((3 << 11) | 20) & 0xFu; }
#define XB_SPIN(cond, bar) do { unsigned _sp = 0; while (cond) { __builtin_amdgcn_s_sleep(1); \
    if ((++_sp & 255u) == 0u) { if (xb_ld(&(bar)[XB_TMO])) break; if (_sp > XB_SPIN_CAP) { atomicAdd(&(bar)[XB_TMO], 1u); break; } } } } while (0)

struct XcdBarrier {
    unsigned* bar; unsigned x;
    volatile LAS unsigned* st;
};

__device__ __forceinline__ XcdBarrier xcd_barrier_post(unsigned* bar, volatile LAS unsigned* st) {
    XcdBarrier b; b.bar = bar; b.x = xb_xcc_id(); b.st = st;
    if (threadIdx.x == 0) (void)xb_add(&bar[XB_XCNT(b.x)], 1u);
    return b;
}
__device__ __forceinline__ void xcd_barrier_complete(unsigned* bar, unsigned x, unsigned& nloc, unsigned& nx) {
    const unsigned G = gridDim.x * gridDim.y * gridDim.z;
    unsigned sum, cnt, mine, sp = 0u;
    for (;;) {
        sum = 0u; cnt = 0u; mine = 0u;
#pragma unroll
        for (unsigned j = 0; j < 16; ++j) { const unsigned c = xb_ld(&bar[XB_XCNT(j)]); sum += c; cnt += (c > 0u) ? 1u : 0u; mine = (j == x) ? c : mine; }
        if (sum == G) break;
        __builtin_amdgcn_s_sleep(1);
        if ((++sp & 255u) == 0u) { if (xb_ld(&bar[XB_TMO])) break; if (sp > XB_SPIN_CAP) { atomicAdd(&bar[XB_TMO], 1u); break; } }
    }
    nloc = mine > 0u ? mine : 1u; nx = cnt > 0u ? cnt : 1u;
}

__device__ __forceinline__ void xcd_barrier(const XcdBarrier& b) {
    asm volatile("s_waitcnt vmcnt(0)" ::: "memory");
    __syncthreads();
    if (threadIdx.x == 0) {
        unsigned* bar = b.bar;
        __builtin_amdgcn_s_waitcnt(0);
        unsigned nloc = b.st[0], nx = b.st[1];
        if (nloc == 0u) { xcd_barrier_complete(bar, b.x, nloc, nx); b.st[0] = nloc; b.st[1] = nx; }
        const unsigned old = xb_add(&bar[XB_XSUB(b.x)], 1u);
        const unsigned gen = old / nloc;
        if (old + 1u == (gen + 1u) * nloc) {
            __builtin_amdgcn_fence(__ATOMIC_RELEASE, "agent");
            asm volatile("s_waitcnt vmcnt(0)" ::: "memory");
            const unsigned og = xb_add(&bar[XB_TOP], 1u);
            const unsigned tg = og / nx;
            if (og + 1u == (tg + 1u) * nx) xb_add(&bar[XB_TOPGEN], 1u);
            else XB_SPIN(xb_ld(&bar[XB_TOPGEN]) == tg, bar);
            __builtin_amdgcn_fence(__ATOMIC_ACQUIRE, "agent");
            xb_add(&bar[XB_XGEN(b.x)], 1u);
            asm volatile("s_waitcnt vmcnt(0)" ::: "memory");
        } else {
            XB_SPIN(xb_ld(&bar[XB_XGEN(b.x)]) == gen, bar);
            __builtin_amdgcn_fence(__ATOMIC_ACQUIRE, "agent");
            asm volatile("s_waitcnt vmcnt(0)" ::: "memory");
        }
    }
    __syncthreads();
}
constexpr int CW_BAR = 4096;
constexpr size_t CTL_ZERO_BYTES = 65536;
constexpr int MISC_OFF = 131072 + 320;

__device__ __forceinline__ void build_rstd_table(const float* part, const pg8::StaticOrder& S, int tid) {
    LAS float* tbl = (LAS float*)pg8::RSTD_TBL_OFF; pg8::Unit u;
    for (int i = 0; i < 8 && S.next(i, u); ++i)
        if (tid < 256) { const f32x4* pp = (const f32x4*)(part + (size_t)(u.pm * 256 + tid) * 16);
            const f32x4 p0 = pp[0], p1 = pp[1], p2 = pp[2], p3 = pp[3]; const f32x4 ps = (p0 + p1) + (p2 + p3);
            tbl[i * 256 + tid] = __builtin_amdgcn_rsqf(((ps[0] + ps[1]) + (ps[2] + ps[3])) * (1.0f / 1024.0f) + EPS); }
    __syncthreads();
}

struct Args { const float* in[14]; float* out; unsigned char* ws; };
enum { I_X = 0, I_N1G, I_WIN, I_QG, I_KG, I_SGG, I_SGW, I_SGB, I_CONVW, I_WOUT, I_N2G, I_WUP, I_FCW, I_WDOWN };

__global__ void __launch_bounds__(NWAVES * 64, 2) mk_fwd(Args args) {
    extern __shared__ __attribute__((aligned(16))) unsigned char lds_raw[];
    LAS unsigned char* lds = (LAS unsigned char*)lds_raw;
    cg::grid_group grid = cg::this_grid();
    for (int u = threadIdx.x; u < (LDS_BYTES - 131072) / 4; u += NWAVES * 64) ((LAS unsigned*)(lds + 131072))[u] = 0u;
    __syncthreads();
    (void)xcd_barrier_post((unsigned*)args.ws + CW_BAR, (volatile LAS unsigned*)(lds + MISC_OFF) + 8);
    grid.sync();
#ifndef REP_SYNC
#define REP_SYNC 1
#endif
#ifndef REP_P1
#define REP_P1 1
#endif
#ifndef REP_P1B
#define REP_P1B 1
#endif
#ifndef REP_ATT
#define REP_ATT 1
#endif
#ifndef REP_P4
#define REP_P4 1
#endif
#define GSYNC() do { for (int r_ = 0; r_ < REP_SYNC; ++r_) { XcdBarrier bar_; bar_.bar = (unsigned*)args.ws + CW_BAR; bar_.x = xb_xcc_id(); bar_.st = (volatile LAS unsigned*)(lds + MISC_OFF) + 8; xcd_barrier(bar_); } } while (0)
#ifndef PHMASK
#define PHMASK 0xff
#endif
#define PH(k) ((PHMASK >> (k)) & 1)
#define PHASE_VARS() PHASE_VARS_L(l)
#define PHASE_VARS_L(LAYER) int tid = threadIdx.x; asm volatile("" : "+v"(tid)); const int lane = tid & 63, wave = __builtin_amdgcn_readfirstlane(tid >> 6); \
    const int G = gridDim.x, bx = blockIdx.x; const int vcu = (G % 8 == 0) ? (bx % 8) * (G / 8) + bx / 8 : bx; const int NGW = G * NWAVES; const int gw = vcu * NWAVES + wave; (void)NGW; \
    GAS unsigned char* wsg_ = (GAS unsigned char*)args.ws; asm volatile("" : "+s"(wsg_)); unsigned char* ws = (unsigned char*)wsg_;     (void)lane; (void)gw; \
    float* part1 = (float*)(ws + WS_PART1); float* part2 = (float*)(ws + WS_PART2); bf16* sgw_b = (bf16*)(ws + WS_SGW); \
    unsigned char* wset = ws + WS_WSET + (size_t)(LAYER & 1) * WSET_BYTES; unsigned char* wnext = ws + WS_WSET + (size_t)((LAYER + 1) & 1) * WSET_BYTES; (void)wnext; \
    bf16* Win_t = (bf16*)(wset + WO_WIN); bf16* Wout_t = (bf16*)(wset + WO_WOUT); bf16* Wup_t = (bf16*)(wset + WO_WUP); bf16* Wdown_t = (bf16*)(wset + WO_WDOWN); \
    bf16* xb = (bf16*)(ws + WS_XB); float* halo = (float*)(ws + WS_HALO); bf16* praw = (bf16*)(ws + WS_PRAW); \
    bf16* qb = (bf16*)(ws + WS_Q); bf16* kb = (bf16*)(ws + WS_K); bf16* vb = (bf16*)(ws + WS_V); bf16* mix = (bf16*)(ws + WS_MIX); bf16* act = (bf16*)(ws + WS_ACT); \
    const float* x_in = args.in[I_X]; float* xres = args.out; LAS float* scr = (LAS float*)(lds + wave * 16384); \
    (void)part1; (void)part2; (void)sgw_b; (void)Win_t; (void)Wout_t; (void)Wup_t; (void)Wdown_t; (void)xb; (void)halo; (void)praw; (void)qb; (void)kb; (void)vb; (void)mix; (void)act; (void)x_in; (void)xres; (void)scr

    if (PH(0)) {
    PHASE_VARS_L(0);
    for (int m = gw; m < MTOK; m += NGW) {
        const f32x4* xr = (const f32x4*)(x_in + (size_t)m * DMODEL) + lane;
        unsigned long long* o8 = (unsigned long long*)(xb + (size_t)m * DMODEL) + lane;
        float ss = 0.f;
#pragma unroll
        for (int j = 0; j < 4; ++j) { const f32x4 v = xr[64 * j]; ss += (v[0] * v[0] + v[1] * v[1]) + (v[2] * v[2] + v[3] * v[3]);
            o8[64 * j] = (unsigned long long)pk2(v[0], v[1]) | ((unsigned long long)pk2(v[2], v[3]) << 32); }
        ss = wave_sum(ss);
        if (lane < 16) part1[(size_t)m * 16 + lane] = lane == 0 ? ss : 0.f;
    }
    { const float* sgw = args.in[I_SGW]; const int n8 = DEPTH * 4 * 128 * 128 / 8;
      for (int i = bx * 512 + tid; i < n8; i += G * 512) { const f32x4 a = *(const f32x4*)(sgw + (size_t)i * 8), b = *(const f32x4*)(sgw + (size_t)i * 8 + 4);
          u32x4 w; w.x = pk2(a[0], a[1]); w.y = pk2(a[2], a[3]); w.z = pk2(b[0], b[1]); w.w = pk2(b[2], b[3]); *(u32x4*)(sgw_b + (size_t)i * 8) = w; } }
    { const ConvJob j0{args.in[I_WIN], args.in[I_N1G], Win_t, DMODEL, PROJ_W, 2}, j1{args.in[I_WOUT], nullptr, Wout_t, DMODEL, DMODEL, 0},
                    j2{args.in[I_WUP], args.in[I_N2G], Wup_t, DMODEL, D_FF2, 1}, j3{args.in[I_WDOWN], nullptr, Wdown_t, D_FF, DMODEL, 0};
      convert_weights(j0, j1, j2, j3, 4, scr, gw, NGW, lane); }
    }
    GSYNC();

#pragma unroll 1
    for (int l = 0; l < DEPTH; ++l) {
        for (int rp = 0; rp < REP_P1; ++rp) if (PH(1)) { PHASE_VARS();
          pg8::Gemm g{xb, Win_t, MTOK, PROJ_W, DMODEL}; pg8::StaticOrder S; S.init(MTOK, PROJ_W, G, bx);
          pg8::EpiInProj E{praw, PROJ_W, kb, vb, args.in[I_KG] + l * 64}; build_rstd_table(part1, S, tid);
          pg8::gemm_phase<pg8::EpiInProj, pg8::StaticOrder, false, true>(lds, g, S, E, tid); }
        GSYNC();
        for (int rp = 0; rp < REP_ATT; ++rp) if (PH(3)) { PHASE_VARS();
          const attn_body::AttnTensors AT{(const attn_body::bf16*)praw, (const attn_body::bf16*)kb, (const attn_body::bf16*)vb, (attn_body::bf16*)mix, args.in[I_QG] + l * 64};
          const attn_body::StaticOrder S(G, vcu);
          float gqm = fabsf(args.in[I_QG][l * 64 + lane]), gkm = fabsf(args.in[I_KG][l * 64 + lane]);
#pragma unroll
          for (int o = 1; o < 64; o <<= 1) { gqm = fmaxf(gqm, __shfl_xor(gqm, o)); gkm = fmaxf(gkm, __shfl_xor(gkm, o)); }
          const bool fixed_ref = __builtin_amdgcn_readfirstlane((gqm * gkm < 4.0f) ? 1 : 0) != 0;
          if (fixed_ref) attn_body::attn_phase<attn_body::StaticOrder, 8, false>((char*)lds_raw, AT, S, tid);
          else attn_body::attn_phase<attn_body::StaticOrder, 8, true>((char*)lds_raw, AT, S, tid);
          for (int it = vcu; it < 256; it += G)
              sg_item(lds, it, praw, sgw_b + (size_t)l * 4 * 128 * 128, args.in[I_SGB] + l * 4 * 128, args.in[I_SGG] + l * 256, mix, wave, lane);
          p1b_rows(praw, mix, args.in[I_CONVW] + l * 3 * 256, gw, NGW, lane); }
        GSYNC();
        if (PH(4)) { PHASE_VARS();
          pg8::Gemm g{mix, Wout_t, MTOK, DMODEL, DMODEL}; pg8::StaticOrder S; S.init(MTOK, DMODEL, G, bx);
          pg8::EpiResid E{xb, part2, nullptr};
          pg8::gemm_phase<pg8::EpiResid, pg8::StaticOrder, true, true>(lds, g, S, E, tid); }
        GSYNC();
        for (int rp = 0; rp < REP_P4; ++rp) if (PH(5)) { PHASE_VARS();
          pg8::Gemm g{xb, Wup_t, MTOK, D_FF2, DMODEL}; pg8::StaticOrder S; S.init(MTOK, D_FF2, G, bx);
          pg8::EpiConvAct E{act, args.in[I_FCW] + (size_t)l * 3 * D_FF2, (long)WS_HALO - (long)WS_ACT}; build_rstd_table(part2, S, tid);
          pg8::gemm_phase<pg8::EpiConvAct, pg8::StaticOrder, true, true>(lds, g, S, E, tid); }
          if (PH(5) && l + 1 < DEPTH) { PHASE_VARS();
              const int nu = (MTOK / 256) * (D_FF2 / 256), rem = nu % G, first = rem ? rem : 0, nidle = G - first;
              if (bx >= first) { const int ln = l + 1; const int gw2 = (bx - first) * NWAVES + wave, NGW2 = nidle * NWAVES;
                  const ConvJob j0{args.in[I_WIN] + (size_t)ln * DMODEL * PROJ_W, args.in[I_N1G] + ln * DMODEL, (bf16*)(wnext + WO_WIN), DMODEL, PROJ_W, 2},
                                j1{args.in[I_WOUT] + (size_t)ln * DMODEL * DMODEL, nullptr, (bf16*)(wnext + WO_WOUT), DMODEL, DMODEL, 0},
                                j2{args.in[I_WUP] + (size_t)ln * DMODEL * D_FF2, args.in[I_N2G] + ln * DMODEL, (bf16*)(wnext + WO_WUP), DMODEL, D_FF2, 1},
                                j3{args.in[I_WDOWN] + (size_t)ln * D_FF * DMODEL, nullptr, (bf16*)(wnext + WO_WDOWN), D_FF, DMODEL, 0};
                  convert_weights(j0, j1, j2, j3, 4, scr, gw2, NGW2, lane); } }
        GSYNC();
        if (PH(7)) { PHASE_VARS();
          pg8::Gemm g{act, Wdown_t, MTOK, DMODEL, D_FF}; pg8::StaticOrder S; S.init(MTOK, DMODEL, G, bx);
          { pg8::Unit u; for (int i = 0; S.next(i, u); ++i) act_fixup(u.pm, halo, args.in[I_FCW] + (size_t)l * 3 * D_FF2, act, tid); }
          asm volatile("s_waitcnt vmcnt(0)" ::: "memory"); __syncthreads();
          pg8::EpiResid E{xb, part1, l + 1 == DEPTH ? xres : nullptr};
          pg8::gemm_phase<pg8::EpiResid, pg8::StaticOrder, true, true>(lds, g, S, E, tid); }
        if (l + 1 < DEPTH) GSYNC();
    }
}

extern "C" void kernel_launch(void* const* d_in, const int* in_sizes, int n_in, void* d_out, int out_size, void* d_ws, size_t ws_size, hipStream_t stream) {
    static int grid = 0;
    if (grid == 0) {
        if (n_in != 14 || out_size != MTOK * DMODEL || ws_size < WS_END) { fprintf(stderr, "kernel_launch: unexpected shapes / workspace (n_in %d out %d ws %zu, need %zu)\n", n_in, out_size, ws_size, (size_t)WS_END); grid = -1; return; }
        int dev = 0, cus = 0, per_cu = 0;
        hipGetDevice(&dev);
        hipDeviceGetAttribute(&cus, hipDeviceAttributeMultiprocessorCount, dev);
        hipFuncSetAttribute((const void*)mk_fwd, hipFuncAttributeMaxDynamicSharedMemorySize, LDS_BYTES);
        hipOccupancyMaxActiveBlocksPerMultiprocessor(&per_cu, (const void*)mk_fwd, NWAVES * 64, LDS_BYTES);
        if (per_cu < 1) per_cu = 1;
        grid = cus * per_cu;
        if (grid < 176) { fprintf(stderr, "kernel_launch: grid %d too small for the per-phase tables (needs >= 176 workgroups)\n", grid); grid = -1; return; }
        (void)hipGetLastError();
    }
    if (grid < 0) return;
    Args a{};
    for (int i = 0; i < 14; ++i) a.in[i] = (const float*)d_in[i];
    a.out = (float*)d_out; a.ws = (unsigned char*)d_ws;
    if (hipMemsetAsync(d_ws, 0, CTL_ZERO_BYTES, stream) != hipSuccess) { fprintf(stderr, "memset failed\n"); return; }
    void* kargs[] = {&a};
    hipError_t e = hipLaunchCooperativeKernel((const void*)mk_fwd, dim3(grid), dim3(NWAVES * 64), kargs, LDS_BYTES, stream);
    if (e != hipSuccess) fprintf(stderr, "cooperative launch failed: %s (grid %d)\n", hipGetErrorString(e), grid);
}
```
